# Optimizing an MI355X kernel written in HIP

```python
import math
import jax, jax.numpy as jnp
from jax import lax
import numpy as np

D_MODEL = 2048
BATCH = 1
SEQ = 16384
DEPTH = 2

CHUNK = 64
SSM_WIDTH = D_MODEL // 2
SSM_GROUP = 16
SSM_GROUPS = SSM_WIDTH // SSM_GROUP
SSM_STATE = 64
SSM_DT_MIN = 0.001
SSM_DT_MAX = 0.1
GDN_HEADS = 8
GDN_DK = 128
GDN_DV = 128
GDN_KDIM = GDN_HEADS * GDN_DK
GDN_VDIM = GDN_HEADS * GDN_DV
GDN_CONV_CH = 2 * GDN_KDIM + GDN_VDIM
CONV_WIDTH = 4
GDN_DT_MIN = 0.001
GDN_DT_MAX = 0.1
GDN_A_MAX = 16.0
FFN_HIDDEN = -(-8 * D_MODEL // (3 * 256)) * 256
IN_SIZES = (SSM_WIDTH, GDN_KDIM, GDN_KDIM, GDN_VDIM, GDN_VDIM, GDN_HEADS, GDN_HEADS, D_MODEL, D_MODEL)
PROJ_IN = sum(IN_SIZES)
DEEPNORM_ALPHA = (2 * DEPTH) ** 0.25
DEEPNORM_BETA = (8 * DEPTH) ** -0.25
LN_EPS = 1e-5
NORM_EPS = 1e-6

kernel_name = 'hybrid_s5_gdn_deepnorm_adaln'


def layer_norm(x, gain=None, bias=None):
    xf = x.astype(jnp.float32)
    mu = xf.mean(-1, keepdims=True)
    var = jnp.square(xf - mu).mean(-1, keepdims=True)
    y = (xf - mu) * lax.rsqrt(var + LN_EPS)
    if gain is not None:
        y = y * gain.astype(jnp.float32) + bias.astype(jnp.float32)
    return y.astype(x.dtype)


def causal_dwconv(x, w):
    k = w.shape[0]
    xp = jnp.pad(x, ((0, 0), (k - 1, 0), (0, 0)))
    return lax.conv_general_dilated(xp, w.astype(x.dtype)[:, None, :], window_strides=(1,), padding='VALID',
                                    dimension_numbers=('NWC', 'WIO', 'NWC'), feature_group_count=x.shape[-1])


def s5_mixer(u, lam_re, lam_im, log_dt, b_re, b_im, c_re, c_im, d_skip, w_glu, b_glu):
    f32 = jnp.float32
    bsz, seq, _ = u.shape
    uf = u.astype(f32).reshape(bsz, seq, SSM_GROUPS, SSM_GROUP)
    lr, li = lam_re.astype(f32), lam_im.astype(f32)
    dt = jnp.exp(log_dt.astype(f32))[:, None]
    mag = jnp.exp(lr * dt)
    ang = li * dt
    ab_re, ab_im = mag * jnp.cos(ang), mag * jnp.sin(ang)
    den = lr * lr + li * li
    nr, ni = ab_re - 1.0, ab_im
    f_re = (nr * lr + ni * li) / den
    f_im = (ni * lr - nr * li) / den
    br, bi = b_re.astype(f32), b_im.astype(f32)
    bb_re = f_re[..., None] * br - f_im[..., None] * bi
    bb_im = f_re[..., None] * bi + f_im[..., None] * br
    bu_re = jnp.einsum('blgh,gph->blgp', uf, bb_re)
    bu_im = jnp.einsum('blgh,gph->blgp', uf, bb_im)
    a_re = jnp.broadcast_to(ab_re, bu_re.shape)
    a_im = jnp.broadcast_to(ab_im, bu_im.shape)

    def combine(e1, e2):
        a1r, a1i, b1r, b1i = e1
        a2r, a2i, b2r, b2i = e2
        return (a2r * a1r - a2i * a1i, a2r * a1i + a2i * a1r,
                a2r * b1r - a2i * b1i + b2r, a2r * b1i + a2i * b1r + b2i)

    _, _, xs_re, xs_im = lax.associative_scan(combine, (a_re, a_im, bu_re, bu_im), axis=1)
    y = (jnp.einsum('blgp,ghp->blgh', xs_re, c_re.astype(f32))
         - jnp.einsum('blgp,ghp->blgh', xs_im, c_im.astype(f32)))
    y = y.reshape(bsz, seq, SSM_WIDTH) + d_skip.astype(f32) * uf.reshape(bsz, seq, SSM_WIDTH)
    z = jax.nn.gelu(y)
    y = z * jax.nn.sigmoid(z @ w_glu.astype(f32) + b_glu.astype(f32))
    return y.astype(u.dtype)


def chunk_gated_delta_rule(q, k, v, beta, g):
    bsz, seq, nh, dk = q.shape
    dv = v.shape[-1]
    nc = seq // CHUNK

    def to_chunks(t):
        return t.reshape(bsz, nc, CHUNK, nh, -1).transpose(0, 3, 1, 2, 4)

    q, k, v = to_chunks(q), to_chunks(k), to_chunks(v)
    beta = beta.reshape(bsz, nc, CHUNK, nh).transpose(0, 3, 1, 2)
    g_cum = jnp.cumsum(g.reshape(bsz, nc, CHUNK, nh).transpose(0, 3, 1, 2), axis=-1)
    causal = jnp.tril(jnp.ones((CHUNK, CHUNK), dtype=bool))
    strict = jnp.tril(jnp.ones((CHUNK, CHUNK), dtype=bool), k=-1)
    diff = g_cum[..., :, None] - g_cum[..., None, :]
    decay = jnp.exp(jnp.where(causal, diff, -jnp.inf))
    k_beta = k * beta[..., None]
    m = jnp.where(strict, jnp.einsum('bhnid,bhnjd->bhnij', k_beta, k) * decay, 0.0)
    eye = jnp.eye(CHUNK, dtype=jnp.float32)
    t_inv = lax.linalg.triangular_solve(eye + m, jnp.broadcast_to(eye, m.shape), left_side=True,
                                        lower=True, unit_diagonal=True)
    u = jnp.einsum('bhnij,bhnjd->bhnid', t_inv, v * beta[..., None])
    w = jnp.einsum('bhnij,bhnjd->bhnid', t_inv, k_beta * jnp.exp(g_cum)[..., None])
    attn = jnp.einsum('bhnid,bhnjd->bhnij', q, k) * decay
    q_dec = q * jnp.exp(g_cum)[..., None]
    k_tail = k * jnp.exp(g_cum[..., -1:] - g_cum)[..., None]
    g_last = jnp.exp(g_cum[..., -1])

    def step(state, xs):
        u_c, w_c, attn_c, qd_c, kt_c, gl_c = xs
        v_new = u_c - jnp.einsum('bhcd,bhde->bhce', w_c, state)
        o_c = jnp.einsum('bhcd,bhde->bhce', qd_c, state) + jnp.einsum('bhij,bhje->bhie', attn_c, v_new)
        state = state * gl_c[..., None, None] + jnp.einsum('bhcd,bhce->bhde', kt_c, v_new)
        return state, o_c

    xs = tuple(jnp.moveaxis(t, 2, 0) for t in (u, w, attn, q_dec, k_tail, g_last))
    s0 = jnp.zeros((bsz, nh, dk, dv), jnp.float32)
    _, o = lax.scan(step, s0, xs)
    return o.transpose(1, 0, 3, 2, 4).reshape(bsz, seq, nh, dv)


def gated_deltanet(q, k, v, z, beta_logit, a_logit, conv_w, a_log, dt_bias, norm_w):
    f32 = jnp.float32
    bsz, seq, _ = q.shape
    qkv = jax.nn.silu(causal_dwconv(jnp.concatenate([q, k, v], axis=-1), conv_w)).astype(f32)
    q, k, v = jnp.split(qkv, [GDN_KDIM, 2 * GDN_KDIM], axis=-1)
    q = q.reshape(bsz, seq, GDN_HEADS, GDN_DK)
    k = k.reshape(bsz, seq, GDN_HEADS, GDN_DK)
    v = v.reshape(bsz, seq, GDN_HEADS, GDN_DV)
    q = q * lax.rsqrt(jnp.sum(q * q, -1, keepdims=True) + NORM_EPS) * (GDN_DK ** -0.5)
    k = k * lax.rsqrt(jnp.sum(k * k, -1, keepdims=True) + NORM_EPS)
    beta = jax.nn.sigmoid(beta_logit.astype(f32))
    g = -jnp.exp(a_log.astype(f32)) * jax.nn.softplus(a_logit.astype(f32) + dt_bias.astype(f32))
    o = chunk_gated_delta_rule(q, k, v, beta, g)
    o = o * lax.rsqrt(jnp.mean(o * o, -1, keepdims=True) + NORM_EPS) * norm_w.astype(f32)
    o = o * jax.nn.silu(z.astype(f32).reshape(bsz, seq, GDN_HEADS, GDN_DV))
    return o.reshape(bsz, seq, GDN_VDIM).astype(z.dtype)


def hybrid_mixer(h, w_in, lam_re, lam_im, log_dt, b_re, b_im, c_re, c_im, d_skip, w_glu, b_glu,
                 conv_w, a_log, dt_bias, norm_w, w_up_ssm, w_up_gdn, w_out):
    splits = np.cumsum(IN_SIZES)[:-1].tolist()
    u, q, k, v, z, beta_l, a_l, gate_s, gate_g = jnp.split(h @ w_in, splits, axis=-1)
    y_s = s5_mixer(u, lam_re, lam_im, log_dt, b_re, b_im, c_re, c_im, d_skip, w_glu, b_glu) @ w_up_ssm
    y_g = gated_deltanet(q, k, v, z, beta_l, a_l, conv_w, a_log, dt_bias, norm_w) @ w_up_gdn
    merged = jax.nn.sigmoid(gate_s) * y_s + jax.nn.sigmoid(gate_g) * y_g
    return merged @ w_out


def swiglu(h, w_in, w_out):
    gate, up = jnp.split(h @ w_in, 2, axis=-1)
    return (jax.nn.silu(gate) * up) @ w_out


def setup_inputs(seed: int = 0) -> dict:
    key = jax.random.key(seed)
    keys = iter(jax.random.split(key, 40))
    f32 = jnp.float32
    nl = DEPTH

    def normal(shape, scale):
        return scale * jax.random.normal(next(keys), shape, f32)

    def uniform(shape, lo, hi):
        return jax.random.uniform(next(keys), shape, f32, lo, hi)

    x = normal((BATCH, SEQ, D_MODEL), 1.0)
    c = normal((BATCH, D_MODEL), 1.0)
    w_ada = normal((nl, D_MODEL, 6 * D_MODEL), D_MODEL ** -0.5)
    b_ada = normal((nl, 6 * D_MODEL), 0.02)
    w_in = normal((nl, D_MODEL, PROJ_IN), D_MODEL ** -0.5)
    n_idx = jnp.arange(SSM_STATE, dtype=f32)
    ssm_lam_re = -0.5 + normal((nl, SSM_GROUPS, SSM_STATE), 0.01)
    ssm_lam_im = math.pi * n_idx + normal((nl, SSM_GROUPS, SSM_STATE), 0.01)
    ssm_log_dt = uniform((nl, SSM_GROUPS), math.log(SSM_DT_MIN), math.log(SSM_DT_MAX))
    ssm_b_re = normal((nl, SSM_GROUPS, SSM_STATE, SSM_GROUP), (2 * SSM_GROUP) ** -0.5)
    ssm_b_im = normal((nl, SSM_GROUPS, SSM_STATE, SSM_GROUP), (2 * SSM_GROUP) ** -0.5)
    ssm_c_re = normal((nl, SSM_GROUPS, SSM_GROUP, SSM_STATE), SSM_STATE ** -0.5)
    ssm_c_im = normal((nl, SSM_GROUPS, SSM_GROUP, SSM_STATE), SSM_STATE ** -0.5)
    ssm_d = normal((nl, SSM_WIDTH), 1.0)
    ssm_w_glu = normal((nl, SSM_WIDTH, SSM_WIDTH), SSM_WIDTH ** -0.5)
    ssm_b_glu = normal((nl, SSM_WIDTH), 0.02)
    gdn_conv_w = normal((nl, CONV_WIDTH, GDN_CONV_CH), CONV_WIDTH ** -0.5)
    gdn_a_log = jnp.log(uniform((nl, GDN_HEADS), 1.0, GDN_A_MAX))
    dt = jnp.exp(uniform((nl, GDN_HEADS), math.log(GDN_DT_MIN), math.log(GDN_DT_MAX)))
    gdn_dt_bias = dt + jnp.log(-jnp.expm1(-dt))
    gdn_norm_w = 1.0 + normal((nl, GDN_DV), 0.02)
    w_up_ssm = normal((nl, SSM_WIDTH, D_MODEL), SSM_WIDTH ** -0.5)
    w_up_gdn = normal((nl, GDN_VDIM, D_MODEL), GDN_VDIM ** -0.5)
    w_mix_out = normal((nl, D_MODEL, D_MODEL), DEEPNORM_BETA * D_MODEL ** -0.5)
    ln1_g = 1.0 + normal((nl, D_MODEL), 0.02)
    ln1_b = normal((nl, D_MODEL), 0.02)
    ffn_w_in = normal((nl, D_MODEL, 2 * FFN_HIDDEN), D_MODEL ** -0.5)
    ffn_w_out = normal((nl, FFN_HIDDEN, D_MODEL), DEEPNORM_BETA * FFN_HIDDEN ** -0.5)
    ln2_g = 1.0 + normal((nl, D_MODEL), 0.02)
    ln2_b = normal((nl, D_MODEL), 0.02)
    return {'x': x, 'c': c, 'w_ada': w_ada, 'b_ada': b_ada, 'w_in': w_in,
            'ssm_lam_re': ssm_lam_re, 'ssm_lam_im': ssm_lam_im, 'ssm_log_dt': ssm_log_dt,
            'ssm_b_re': ssm_b_re, 'ssm_b_im': ssm_b_im, 'ssm_c_re': ssm_c_re, 'ssm_c_im': ssm_c_im,
            'ssm_d': ssm_d, 'ssm_w_glu': ssm_w_glu, 'ssm_b_glu': ssm_b_glu,
            'gdn_conv_w': gdn_conv_w, 'gdn_a_log': gdn_a_log, 'gdn_dt_bias': gdn_dt_bias, 'gdn_norm_w': gdn_norm_w,
            'w_up_ssm': w_up_ssm, 'w_up_gdn': w_up_gdn, 'w_mix_out': w_mix_out,
            'ln1_g': ln1_g, 'ln1_b': ln1_b, 'ffn_w_in': ffn_w_in, 'ffn_w_out': ffn_w_out,
            'ln2_g': ln2_g, 'ln2_b': ln2_b}


def reference(x, c, w_ada, b_ada, w_in, ssm_lam_re, ssm_lam_im, ssm_log_dt, ssm_b_re, ssm_b_im,
              ssm_c_re, ssm_c_im, ssm_d, ssm_w_glu, ssm_b_glu, gdn_conv_w, gdn_a_log, gdn_dt_bias,
              gdn_norm_w, w_up_ssm, w_up_gdn, w_mix_out, ln1_g, ln1_b, ffn_w_in, ffn_w_out, ln2_g, ln2_b):
    for l in range(DEPTH):
        mod = (jax.nn.silu(c) @ w_ada[l] + b_ada[l])[:, None, :]
        sh_m, sc_m, g_m, sh_f, sc_f, g_f = jnp.split(mod, 6, axis=-1)
        h = layer_norm(x) * (1 + sc_m) + sh_m
        y = hybrid_mixer(h, w_in[l], ssm_lam_re[l], ssm_lam_im[l], ssm_log_dt[l], ssm_b_re[l], ssm_b_im[l],
                         ssm_c_re[l], ssm_c_im[l], ssm_d[l], ssm_w_glu[l], ssm_b_glu[l],
                         gdn_conv_w[l], gdn_a_log[l], gdn_dt_bias[l], gdn_norm_w[l],
                         w_up_ssm[l], w_up_gdn[l], w_mix_out[l])
        x = layer_norm(DEEPNORM_ALPHA * x + g_m * y, ln1_g[l], ln1_b[l])
        h = layer_norm(x) * (1 + sc_f) + sh_f
        x = layer_norm(DEEPNORM_ALPHA * x + g_f * swiglu(h, ffn_w_in[l], ffn_w_out[l]), ln2_g[l], ln2_b[l])
    return x
```

```cpp
#include <hip/hip_runtime.h>
#include <hip/hip_cooperative_groups.h>
#include <cstdio>
namespace cg = cooperative_groups;

#define LAS __attribute__((address_space(3)))
#define DI __device__ __forceinline__
typedef unsigned short bf16_t;
typedef short bf16x8 __attribute__((ext_vector_type(8)));
typedef float f32x2 __attribute__((ext_vector_type(2)));
typedef float f32x4 __attribute__((ext_vector_type(4)));
typedef float f32x16 __attribute__((ext_vector_type(16)));
typedef unsigned u32x4 __attribute__((ext_vector_type(4)));
typedef unsigned u32x2 __attribute__((ext_vector_type(2)));
typedef __bf16 bf2_t __attribute__((ext_vector_type(2)));

constexpr int L = 16384, DM = 2048, NPROJ = 9472, FH = 5632, NTHR = 512;
constexpr float ALPHA = 1.41421356237f;
constexpr int LDS_BYTES = 143360;

constexpr size_t SZ_WIN = (size_t)NPROJ * DM * 2, SZ_WGLU = 1024ull * 1024 * 2, SZ_WUP = 2048ull * 1024 * 2, SZ_WOUT = 2048ull * 2048 * 2,
                 SZ_WF1 = 11264ull * 2048 * 2, SZ_WF2 = 2048ull * 5632 * 2;
constexpr size_t O_WIN = 0, O_WGLU = O_WIN + SZ_WIN, O_WUPS = O_WGLU + SZ_WGLU, O_WUPG = O_WUPS + SZ_WUP, O_WOUT = O_WUPG + SZ_WUP,
                 O_WF1 = O_WOUT + SZ_WOUT, O_WF2 = O_WF1 + SZ_WF1;
constexpr size_t SZ_BT2 = 64ull * 512 * 640 * 2, SZ_M2 = 64ull * 256 * 512 * 2;
constexpr size_t O_BT2 = O_WF2 + SZ_WF2, O_M2 = O_BT2 + SZ_BT2;
constexpr size_t SZ_A = (size_t)L * FH * 2;
constexpr size_t O_A = O_M2 + SZ_M2;
constexpr size_t FRAG_ITEM = 57344, UFR_ITEM = 32768;
constexpr size_t O_UFR = O_A + 2048 * FRAG_ITEM;
constexpr size_t O_Y2 = O_A, O_T1 = O_A + (size_t)L * 1024 * 2, O_MRG = O_T1 + (size_t)L * 2048 * 2;
constexpr size_t SZ_B = (size_t)L * DM * 4;
constexpr size_t O_B = O_A + SZ_A, O_QKV = O_B, O_Z = O_B + (size_t)L * 3072 * 2;
constexpr size_t O_C = O_B + SZ_B, O_SGS = O_C, O_SGG = O_C + (size_t)L * 2048 * 2;
constexpr size_t O_D = O_C + 2 * (size_t)L * 2048 * 2;
constexpr size_t O_ZS = O_D, O_OBF = O_D + (size_t)L * 1024 * 2;
constexpr size_t O_E = O_D + (size_t)L * 2048 * 2;
constexpr size_t O_LOG = O_E + 64ull * 512 * 640 * 2;
constexpr size_t O_XEND = O_LOG + (size_t)L * 16 * 4;
constexpr size_t O_MOD = O_XEND + 64ull * 512 * 128 * 4;
constexpr size_t O_A32 = O_MOD + 2 * 12288 * 4;
constexpr size_t O_GL = O_A32 + 64 * 64 * 2 * 4;
constexpr size_t WS_END = O_GL + 8 * 256 * 4;

struct Params {
    const float* in[28];
    float* out;
    unsigned char* ws;
};

extern "C" __device__ size_t __ockl_get_num_groups(unsigned);
typedef const __attribute__((address_space(4))) Params* PP;
DI int TID() { int t = __builtin_amdgcn_workitem_id_x(); asm volatile("" : "+v"(t)); return t; }
DI int GDIM() { return (int)__ockl_get_num_groups(0); }
DI int BID() { int t = __builtin_amdgcn_workgroup_id_x(); asm volatile("" : "+s"(t)); return t; }
DI unsigned pk2(float lo, float hi) { f32x2 v = {lo, hi}; bf2_t b = __builtin_convertvector(v, bf2_t); return __builtin_bit_cast(unsigned, b); }
DI bf16_t f2bf(float f) { return (bf16_t)(pk2(f, 0.f) & 0xffffu); }
DI float bflo(unsigned w) { return __uint_as_float(w << 16); }
DI float bfhi(unsigned w) { return __uint_as_float(w & 0xffff0000u); }
DI void unpack8(u32x4 w, float* f) { f[0] = bflo(w.x); f[1] = bfhi(w.x); f[2] = bflo(w.y); f[3] = bfhi(w.y); f[4] = bflo(w.z); f[5] = bfhi(w.z); f[6] = bflo(w.w); f[7] = bfhi(w.w); }
DI u32x4 pack8(const float* f) { u32x4 w; w.x = pk2(f[0], f[1]); w.y = pk2(f[2], f[3]); w.z = pk2(f[4], f[5]); w.w = pk2(f[6], f[7]); return w; }
DI u32x4 pack44(f32x4 a, f32x4 b) { u32x4 w; w.x = pk2(a[0], a[1]); w.y = pk2(a[2], a[3]); w.z = pk2(b[0], b[1]); w.w = pk2(b[2], b[3]); return w; }
DI float sigmoidf_(float x) { return 1.f / (1.f + __expf(-x)); }
DI float siluf_(float x) { return x / (1.f + __expf(-x)); }
DI float gelu_tanh(float y) { float t = 0.7978845608f * (y + 0.044715f * y * y * y); float e = __expf(2.f * t); return 0.5f * y * (2.f - 2.f / (e + 1.f)); }
DI int crow(int reg, int h) { return (reg & 3) + 8 * (reg >> 2) + 4 * h; }
#define MFMA32(a, b, c) __builtin_amdgcn_mfma_f32_32x32x16_bf16((a), (b), (c), 0, 0, 0)

namespace pg8 {
constexpr int BM = 256, BK = 64, HALF = 128, HTB = HALF * BK * 2, STAGE_BYTES = 8 * HTB, NXCD = 8, WGM = 8;
DI int lds_byte(int r, int c) { const int st = (r >> 4) * 2 + (c >> 5), rr = r & 15, cc = c & 31, ob = rr * 64 + cc * 2; return st * 1024 + (ob ^ (((ob >> 9) & 1) << 5)); }
DI void stage_rc(int b, int& R, int& C) { const int st = b / 1024, sb = b % 1024, swz = sb ^ (((sb >> 9) & 1) << 5); R = (st >> 1) * 16 + swz / 64; C = (st & 1) * 32 + (swz % 64) / 2; }
DI int perm32(int rho) { const int n = rho >> 4, i = rho & 15; return 8 * (i >> 2) + 4 * n + (i & 3); }
struct Unit { int pm, pn; };
struct Gemm { const bf16_t* A; const bf16_t* Bt; int lda, ldb, K; };

struct StaticOrder {
    int nM, nN, nwg, G, c;
    DI void init(int M, int N, int G_, int c_) { nM = M / BM; nN = N / BM; nwg = nM * nN; G = G_; c = c_; }
    DI bool next(int i, Unit& u) const {
        const long Li = (long)i * G + c; if (c < 0 || Li >= nwg) return false;
        int wgid = (int)Li; { const int q = nwg / NXCD, r = nwg % NXCD, xcd = wgid % NXCD, off = wgid / NXCD; wgid = (xcd < r ? xcd * (q + 1) : r * (q + 1) + (xcd - r) * q) + off; }
        const int nig = WGM * nN, gid = wgid / nig, fm = gid * WGM, gsz = (nM - fm) < WGM ? (nM - fm) : WGM;
        u.pm = fm + ((wgid % nig) % gsz); u.pn = (wgid % nig) / gsz; return true;
    }
};
struct OrderS5Y { int G, c; DI bool next(int i, Unit& u) const { const int Li = i * G + c; if (c < 0 || Li >= 256) return false; const int g = Li >> 2; u.pm = 2 * g + ((Li >> 1) & 1); u.pn = 2 * g + (Li & 1); return true; } };
struct OrderS5X { int G, c; DI bool next(int i, Unit& u) const { const int Li = i * G + c; if (c < 0 || Li >= 128) return false; const int g = Li >> 1; u.pm = 2 * g + (Li & 1); u.pn = g; return true; } };

template <class Epi, class Sched>
DI void gemm_phase(LAS unsigned char* lds, const Gemm g, const Sched& S, const Epi& E) {
    const int tid = TID(), wid = __builtin_amdgcn_readfirstlane(tid >> 6), lane = tid & 63, wr = wid >> 2, wc = wid & 3, fr = lane & 15, fq = lane >> 4;
    const int K = g.K, nt = K / BK;
    unsigned voffA[2], voffB[2];
#pragma unroll
    for (int i = 0; i < 2; ++i) { int R, C; stage_rc(tid * 16 + i * 8192, R, C); const int Rb = Epi::PERM ? ((R & ~31) + perm32(R & 31)) : R;
        voffA[i] = (unsigned)(R * g.lda + C) * 2u; voffB[i] = (unsigned)(Rb * g.ldb + C) * 2u; }
    const size_t kstep = (size_t)(BK * 2);
    const size_t hstepA = (size_t)HALF * g.lda * 2, hstepB = (size_t)HALF * g.ldb * 2;
    const size_t tstepA = 2 * hstepA, tstepB = 2 * hstepB;
    const unsigned ldsw = (unsigned)wid * 1024u;
    const int aoff = lds_byte(wr * 64 + fr, fq * 8), boff = lds_byte(wc * 32 + fr, fq * 8);
#define PG8_SA(b, h) (((b) * 2 + (h)) * HTB)
#define PG8_SB(b, h) ((4 + (b) * 2 + (h)) * HTB)
#define PG8_STAGE(bufoff, gbase, voff) do { _Pragma("unroll") for (int _i = 0; _i < 2; ++_i) \
        __builtin_amdgcn_global_load_lds((const unsigned*)((const char*)(gbase) + (voff)[_i]), (LAS unsigned*)(lds + (bufoff) + ldsw + _i * 8192), 16, 0, 0); } while (0)
#define PG8_LDA(dst, b, h) do { _Pragma("unroll") for (int m = 0; m < 4; ++m) _Pragma("unroll") for (int k = 0; k < 2; ++k) dst[m][k] = *(const LAS bf16x8*)(lds + PG8_SA(b, h) + aoff + m * 2048 + k * 1024); } while (0)
#define PG8_LDB(dst, b, h) do { _Pragma("unroll") for (int n = 0; n < 2; ++n) _Pragma("unroll") for (int k = 0; k < 2; ++k) dst[n][k] = *(const LAS bf16x8*)(lds + PG8_SB(b, h) + boff + n * 2048 + k * 1024); } while (0)
#define PG8_MMA(ai, bj, At, Bt) do { __builtin_amdgcn_s_setprio(1); _Pragma("unroll") for (int m = 0; m < 4; ++m) _Pragma("unroll") for (int n = 0; n < 2; ++n) _Pragma("unroll") for (int k = 0; k < 2; ++k) \
        acc[ai][bj][m][n] = __builtin_amdgcn_mfma_f32_16x16x32_bf16(Bt[n][k], At[m][k], acc[ai][bj][m][n], 0, 0, 0); __builtin_amdgcn_s_setprio(0); } while (0)
#define PG8_WAIT_V(n) asm volatile("s_waitcnt vmcnt(" #n ")" ::: "memory")
#define PG8_WAIT_L(n) asm volatile("s_waitcnt lgkmcnt(" #n ")" ::: "memory")
#define PG8_BAR __builtin_amdgcn_s_barrier()
#define PG8_SCHED __builtin_amdgcn_sched_barrier(0)
    Unit cur, nxt; int ui = 0;
    if (!S.next(0, cur)) return;
    f32x4 acc[2][2][4][2];
#pragma unroll
    for (int a = 0; a < 2; ++a)
#pragma unroll
        for (int b = 0; b < 2; ++b)
#pragma unroll
            for (int m = 0; m < 4; ++m)
#pragma unroll
                for (int n = 0; n < 2; ++n) acc[a][b][m][n] = (f32x4){0.f, 0.f, 0.f, 0.f};
    bf16x8 At[4][2], B0[2][2], B1[2][2];
    const char* cA = (const char*)g.A + (size_t)cur.pm * tstepA; const char* cB = (const char*)g.Bt + (size_t)cur.pn * tstepB;
    PG8_STAGE(PG8_SB(0, 0), cB, voffB); PG8_STAGE(PG8_SA(0, 0), cA, voffA); PG8_STAGE(PG8_SB(0, 1), cB + hstepB, voffB); PG8_STAGE(PG8_SA(0, 1), cA + hstepA, voffA);
    if (wr == 1) PG8_BAR;
    PG8_WAIT_V(4); PG8_BAR;
    PG8_STAGE(PG8_SB(1, 0), cB + kstep, voffB); PG8_STAGE(PG8_SA(1, 0), cA + kstep, voffA); PG8_STAGE(PG8_SB(1, 1), cB + hstepB + kstep, voffB);
    PG8_WAIT_V(6); PG8_BAR;
    for (;;) {
        const bool has_next = S.next(ui + 1, nxt);
        const char* nA = has_next ? (const char*)g.A + (size_t)nxt.pm * tstepA : cA; const char* nB = has_next ? (const char*)g.Bt + (size_t)nxt.pn * tstepB : cB;
        for (int t = 0; t < nt; t += 2) {
            const bool last = (t == nt - 2);
            const char* a1 = cA + (size_t)(t + 1) * kstep;
            const char* a2 = last ? nA : cA + (size_t)(t + 2) * kstep; const char* b2 = last ? nB : cB + (size_t)(t + 2) * kstep;
            const char* a3 = a2 + kstep; const char* b3 = b2 + kstep;
            PG8_LDB(B0, 0, 0); PG8_SCHED; PG8_LDA(At, 0, 0); PG8_STAGE(PG8_SA(1, 1), a1 + hstepA, voffA);
            PG8_WAIT_L(8); PG8_BAR; PG8_WAIT_L(0); PG8_MMA(0, 0, At, B0); PG8_BAR; PG8_SCHED;
            PG8_LDB(B1, 0, 1); PG8_STAGE(PG8_SB(0, 0), b2, voffB);
            PG8_BAR; PG8_WAIT_L(0); PG8_MMA(0, 1, At, B1); PG8_BAR;
            PG8_LDA(At, 0, 1); PG8_STAGE(PG8_SA(0, 0), a2, voffA);
            PG8_BAR; PG8_WAIT_L(0); PG8_MMA(1, 0, At, B0); PG8_BAR; PG8_SCHED;
            PG8_STAGE(PG8_SB(0, 1), b2 + hstepB, voffB);
            PG8_WAIT_V(6); PG8_BAR; PG8_MMA(1, 1, At, B1); PG8_BAR;
            PG8_LDB(B0, 1, 0); PG8_SCHED; PG8_LDA(At, 1, 0); PG8_STAGE(PG8_SA(0, 1), a2 + hstepA, voffA);
            PG8_WAIT_L(8); PG8_BAR; PG8_WAIT_L(0); PG8_MMA(0, 0, At, B0); PG8_BAR; PG8_SCHED;
            PG8_LDB(B1, 1, 1); PG8_STAGE(PG8_SB(1, 0), b3, voffB);
            PG8_BAR; PG8_WAIT_L(0); PG8_MMA(0, 1, At, B1); PG8_BAR;
            PG8_LDA(At, 1, 1); PG8_STAGE(PG8_SA(1, 0), a3, voffA);
            PG8_BAR; PG8_WAIT_L(0); PG8_MMA(1, 0, At, B0); PG8_BAR; PG8_SCHED;
            PG8_STAGE(PG8_SB(1, 1), b3 + hstepB, voffB);
            PG8_WAIT_V(6); PG8_BAR; PG8_MMA(1, 1, At, B1); PG8_BAR;
        }
        E(acc, cur, wr, wc, fr, fq);
        if (!has_next) break;
#pragma unroll
        for (int a = 0; a < 2; ++a)
#pragma unroll
            for (int b = 0; b < 2; ++b)
#pragma unroll
                for (int m = 0; m < 4; ++m)
#pragma unroll
                    for (int n = 0; n < 2; ++n) acc[a][b][m][n] = (f32x4){0.f, 0.f, 0.f, 0.f};
        cur = nxt; cA = nA; cB = nB; ++ui;
    }
    PG8_WAIT_V(0);
    if (wr == 0) PG8_BAR;
    PG8_BAR;
#undef PG8_SA
#undef PG8_SB
#undef PG8_STAGE
#undef PG8_LDA
#undef PG8_LDB
#undef PG8_MMA
#undef PG8_WAIT_V
#undef PG8_WAIT_L
#undef PG8_BAR
#undef PG8_SCHED
}

typedef f32x4 Acc[2][2][4][2];
#define EPI_LOOP_PERM(...) _Pragma("unroll") for (int ai = 0; ai < 2; ++ai) _Pragma("unroll") for (int m = 0; m < 4; ++m) { const int row = u.pm * 256 + ai * 128 + wr * 64 + m * 16 + fr; \
    _Pragma("unroll") for (int bj = 0; bj < 2; ++bj) { const int c8 = bj * 128 + wc * 32 + 8 * fq; f32x4 v0 = acc[ai][bj][m][0], v1 = acc[ai][bj][m][1]; __VA_ARGS__ } }

struct EpiProj {
    static constexpr bool PERM = true;
    bf16_t *uperm, *qkv, *z, *sgs, *sgg; float* logit;
    DI void operator()(const Acc& acc, const Unit& u, int wr, int wc, int fr, int fq) const {
        const int pn = u.pn;
        if (pn < 4) {
            EPI_LOOP_PERM({ const int ch = pn * 256 + c8; *(u32x4*)(uperm + ((size_t)((ch >> 4) * 512 + (row >> 5)) * 640 + (row & 31) * 16 + (ch & 15))) = pack44(v0, v1); })
        } else if (pn < 16) {
            EPI_LOOP_PERM({ *(u32x4*)(qkv + (size_t)row * 3072 + (pn - 4) * 256 + c8) = pack44(v0, v1); })
        } else if (pn < 20) {
            EPI_LOOP_PERM({ *(u32x4*)(z + (size_t)row * 1024 + (pn - 16) * 256 + c8) = pack44(v0, v1); })
        } else if (pn < 36) {
            bf16_t* dst = pn < 28 ? sgs + (pn - 20) * 256 : sgg + (pn - 28) * 256;
            EPI_LOOP_PERM({ for (int j = 0; j < 4; ++j) { v0[j] = sigmoidf_(v0[j]); v1[j] = sigmoidf_(v1[j]); } *(u32x4*)(dst + (size_t)row * 2048 + c8) = pack44(v0, v1); })
        } else {
            EPI_LOOP_PERM({ if (bj == 0 && wc == 0 && fq < 2) { *(f32x4*)(logit + (size_t)row * 16 + 8 * fq) = v0; *(f32x4*)(logit + (size_t)row * 16 + 8 * fq + 4) = v1; } })
        }
    }
};
struct EpiXend {
    static constexpr bool PERM = false;
    float* xend;
    DI void operator()(const Acc& acc, const Unit& u, int wr, int wc, int fr, int fq) const {
#pragma unroll
        for (int ai = 0; ai < 2; ++ai)
#pragma unroll
            for (int m = 0; m < 4; ++m) { const int row = u.pm * 256 + ai * 128 + wr * 64 + m * 16 + fr;
#pragma unroll
                for (int n = 0; n < 2; ++n) *(f32x4*)(xend + (size_t)row * 128 + wc * 32 + 16 * n + 4 * fq) = acc[ai][0][m][n]; }
    }
};
struct EpiS5Y {
    static constexpr bool PERM = true;
    const bf16_t* uperm; const float* dskip; bf16_t* zs;
    DI void operator()(const Acc& acc, const Unit& u, int wr, int wc, int fr, int fq) const {
        const int g = u.pm >> 1, mt = u.pm & 1, nt = u.pn & 1;
#pragma unroll
        for (int ai = 0; ai < 2; ++ai)
#pragma unroll
            for (int m = 0; m < 4; ++m) { const int chunk = mt * 256 + ai * 128 + wr * 64 + m * 16 + fr;
#pragma unroll
                for (int bj = 0; bj < 2; ++bj) { const int n0 = nt * 256 + bj * 128 + wc * 32 + 8 * fq; const int t = n0 >> 4, ho0 = n0 & 15;
                    f32x4 v0 = acc[ai][bj][m][0], v1 = acc[ai][bj][m][1];
                    float uf[8]; unpack8(*(const u32x4*)(uperm + (size_t)(g * 512 + chunk) * 640 + n0), uf);
                    const f32x4 d0 = *(const f32x4*)(dskip + g * 16 + ho0), d1 = *(const f32x4*)(dskip + g * 16 + ho0 + 4);
                    for (int j = 0; j < 4; ++j) { v0[j] = gelu_tanh(v0[j] + d0[j] * uf[j]); v1[j] = gelu_tanh(v1[j] + d1[j] * uf[4 + j]); }
                    *(u32x4*)(zs + (size_t)(chunk * 32 + t) * 1024 + g * 16 + ho0) = pack44(v0, v1); } }
    }
};
struct EpiGlu {
    static constexpr bool PERM = true;
    const bf16_t* zs; const float* bias; bf16_t* y2;
    DI void operator()(const Acc& acc, const Unit& u, int wr, int wc, int fr, int fq) const {
        EPI_LOOP_PERM({ const int col = u.pn * 256 + c8; float zf[8]; unpack8(*(const u32x4*)(zs + (size_t)row * 1024 + col), zf);
            const f32x4 b0 = *(const f32x4*)(bias + col), b1 = *(const f32x4*)(bias + col + 4);
            for (int j = 0; j < 4; ++j) { v0[j] = zf[j] * sigmoidf_(v0[j] + b0[j]); v1[j] = zf[4 + j] * sigmoidf_(v1[j] + b1[j]); }
            *(u32x4*)(y2 + (size_t)row * 1024 + col) = pack44(v0, v1); })
    }
};
template <int SECOND> struct EpiUp {
    static constexpr bool PERM = true;
    const bf16_t* gate; const bf16_t* t1in; bf16_t* dst;
    DI void operator()(const Acc& acc, const Unit& u, int wr, int wc, int fr, int fq) const {
        EPI_LOOP_PERM({ const size_t o = (size_t)row * 2048 + u.pn * 256 + c8; float gf[8]; unpack8(*(const u32x4*)(gate + o), gf);
            float tf[8]; if (SECOND) unpack8(*(const u32x4*)(t1in + o), tf); else { for (int j = 0; j < 8; ++j) tf[j] = 0.f; }
            for (int j = 0; j < 4; ++j) { v0[j] = tf[j] + gf[j] * v0[j]; v1[j] = tf[4 + j] + gf[4 + j] * v1[j]; }
            *(u32x4*)(dst + o) = pack44(v0, v1); })
    }
};
struct EpiResid {
    static constexpr bool PERM = false;
    const float* xin; const float* gate; float* out;
    DI void operator()(const Acc& acc, const Unit& u, int wr, int wc, int fr, int fq) const {
#pragma unroll
        for (int ai = 0; ai < 2; ++ai)
#pragma unroll
            for (int m = 0; m < 4; ++m) { const int row = u.pm * 256 + ai * 128 + wr * 64 + m * 16 + fr;
#pragma unroll
                for (int bj = 0; bj < 2; ++bj)
#pragma unroll
                    for (int n = 0; n < 2; ++n) { const int col = u.pn * 256 + bj * 128 + wc * 32 + 16 * n + 4 * fq; const size_t o = (size_t)row * 2048 + col;
                        const f32x4 xv = *(const f32x4*)(xin + o), gv = *(const f32x4*)(gate + col);
                        *(f32x4*)(out + o) = ALPHA * xv + gv * acc[ai][bj][m][n]; } }
    }
};
struct EpiSwiglu {
    static constexpr bool PERM = true;
    bf16_t* a;
    DI void operator()(const Acc& acc, const Unit& u, int wr, int wc, int fr, int fq) const {
#pragma unroll
        for (int ai = 0; ai < 2; ++ai)
#pragma unroll
            for (int m = 0; m < 4; ++m) { const int row = u.pm * 256 + ai * 128 + wr * 64 + m * 16 + fr;
                f32x4 g0 = acc[ai][0][m][0], g1 = acc[ai][0][m][1]; const f32x4 u0 = acc[ai][1][m][0], u1 = acc[ai][1][m][1];
                for (int j = 0; j < 4; ++j) { g0[j] = siluf_(g0[j]) * u0[j]; g1[j] = siluf_(g1[j]) * u1[j]; }
                *(u32x4*)(a + (size_t)row * FH + u.pn * 128 + wc * 32 + 8 * fq) = pack44(g0, g1); }
    }
};
}

template <int MODE> DI int rowmap(int n) {
    if (MODE == 1) return n < 5120 ? n : (n < 5136 ? 9216 + (n - 5120) : n - 16);
    if (MODE == 2) { if (n < 5632) return (n >> 7) * 256 + (n & 127); const int m = n - 5632; return (m >> 7) * 256 + 128 + (m & 127); }
    return n;
}
template <int MODE> DI void transpose_job(LAS unsigned char* lds, const float* src, int K, int N, bf16_t* dst) {
    LAS float* tl = (LAS float*)lds;
    const int tid = TID(), tn = (N + 63) >> 6, tk = K >> 6, ntile = tn * tk;
    for (int t = BID(); t < ntile; t += GDIM()) {
        const int k0 = (t / tn) * 64, n0 = (t % tn) * 64;
#pragma unroll
        for (int i = 0; i < 2; ++i) { const int kk = (tid >> 4) + 32 * i, nn = (tid & 15) * 4;
            f32x4 v = {0.f, 0.f, 0.f, 0.f}; if (n0 + nn < N) v = *(const f32x4*)(src + (size_t)(k0 + kk) * N + n0 + nn);
            tl[kk * 65 + nn] = v[0]; tl[kk * 65 + nn + 1] = v[1]; tl[kk * 65 + nn + 2] = v[2]; tl[kk * 65 + nn + 3] = v[3]; }
        __syncthreads();
        { const int n = tid >> 3, ko = (tid & 7) * 8;
          if (n0 + n < N) { float f[8];
#pragma unroll
              for (int j = 0; j < 8; ++j) f[j] = tl[(ko + j) * 65 + n];
              *(u32x4*)(dst + (size_t)rowmap<MODE>(n0 + n) * K + k0 + ko) = pack8(f); } }
        __syncthreads();
    }
}

DI void phase_weights(LAS unsigned char* lds, PP p, int l) {
    unsigned char* ws = p->ws;
    transpose_job<1>(lds, p->in[4] + (size_t)l * 2048 * 9232, 2048, 9232, (bf16_t*)(ws + O_WIN));
    transpose_job<0>(lds, p->in[13] + (size_t)l * 1024 * 1024, 1024, 1024, (bf16_t*)(ws + O_WGLU));
    transpose_job<0>(lds, p->in[19] + (size_t)l * 1024 * 2048, 1024, 2048, (bf16_t*)(ws + O_WUPS));
    transpose_job<0>(lds, p->in[20] + (size_t)l * 1024 * 2048, 1024, 2048, (bf16_t*)(ws + O_WUPG));
    transpose_job<0>(lds, p->in[21] + (size_t)l * 2048 * 2048, 2048, 2048, (bf16_t*)(ws + O_WOUT));
    transpose_job<2>(lds, p->in[24] + (size_t)l * 2048 * 11264, 2048, 11264, (bf16_t*)(ws + O_WF1));
    transpose_job<0>(lds, p->in[25] + (size_t)l * 5632 * 2048, 5632, 2048, (bf16_t*)(ws + O_WF2));
    { u32x4* z = (u32x4*)(ws + O_WIN + (size_t)9232 * 2048 * 2); const int nz = 240 * 2048 * 2 / 16;
      for (int i = BID() * NTHR + TID(); i < nz; i += GDIM() * NTHR) z[i] = (u32x4){0u, 0u, 0u, 0u}; }
}

DI void phase_mod(LAS unsigned char* lds, PP p) {
    LAS float* red = (LAS float*)lds;
    const int tid = TID(), col = tid & 63, kp = tid >> 6;
    const float* c = p->in[1];
    float* mod = (float*)(p->ws + O_MOD);
    for (int u = BID(); u < 384; u += GDIM()) {
        const int l = u / 192, c0 = (u % 192) * 64;
        const float* w = p->in[2] + (size_t)l * 2048 * 12288 + c0 + col;
        float s = 0.f;
        for (int k = kp * 256; k < kp * 256 + 256; ++k) { const float cv = c[k]; s += (cv / (1.f + expf(-cv))) * w[(size_t)k * 12288]; }
        red[kp * 64 + col] = s;
        __syncthreads();
        if (tid < 64) { float t = 0.f; for (int i = 0; i < 8; ++i) t += red[i * 64 + tid]; mod[l * 12288 + c0 + tid] = t + p->in[3][l * 12288 + c0 + tid]; }
        __syncthreads();
    }
}

DI void phase_s5pre(LAS unsigned char* lds, PP p, int l) {
    LAS float* apr = (LAS float*)lds;
    LAS float* api = apr + 33 * 64;
    LAS float* bbr = api + 33 * 64;
    LAS float* bbi = bbr + 1024;
    LAS float* ccr = bbi + 1024;
    LAS float* cci = ccr + 1024;
    LAS float* kt = cci + 1024;
    const int tid = TID();
    bf16_t* bt2 = (bf16_t*)(p->ws + O_BT2); bf16_t* m2 = (bf16_t*)(p->ws + O_M2); float* a32 = (float*)(p->ws + O_A32);
    for (int g = BID(); g < 64; g += GDIM()) {
        const float dt = expf(p->in[7][l * 64 + g]);
        for (int id = tid; id < 33 * 64; id += NTHR) { const int pp = id & 63, j = id >> 6;
            const float lr = p->in[5][(l * 64 + g) * 64 + pp], li = p->in[6][(l * 64 + g) * 64 + pp];
            const float mg = expf(lr * dt * (float)j), an = li * dt * (float)j; float sn, cs; sincosf(an, &sn, &cs); const float re = mg * cs, im = mg * sn;
            apr[j * 64 + pp] = re; api[j * 64 + pp] = im;
            if (j == 32) { a32[(g * 64 + pp) * 2] = re; a32[(g * 64 + pp) * 2 + 1] = im; } }
        for (int id = tid; id < 1024; id += NTHR) { const int pp = id >> 4, hi = id & 15;
            const float lr = p->in[5][(l * 64 + g) * 64 + pp], li = p->in[6][(l * 64 + g) * 64 + pp];
            const float mg = expf(lr * dt), an = li * dt; float sn, cs; sincosf(an, &sn, &cs); const float nr = mg * cs - 1.0f, ni = mg * sn, den = lr * lr + li * li;
            const float fr = (nr * lr + ni * li) / den, fi = (ni * lr - nr * li) / den;
            const size_t bo = ((size_t)(l * 64 + g) * 64 + pp) * 16 + hi; const float br = p->in[8][bo], bi = p->in[9][bo];
            bbr[id] = fr * br - fi * bi; bbi[id] = fr * bi + fi * br;
            const int ho = id >> 6, p2 = id & 63; const size_t co = ((size_t)(l * 64 + g) * 16 + ho) * 64 + p2;
            ccr[id] = p->in[10][co]; cci[id] = p->in[11][co]; }
        __syncthreads();
        for (int id = tid; id < 32 * 256; id += NTHR) { const int j = id >> 8, ho = (id >> 4) & 15, hi = id & 15; float s = 0.f;
            for (int pp = 0; pp < 64; ++pp) { const float ar = apr[j * 64 + pp], ai = api[j * 64 + pp], br = bbr[pp * 16 + hi], bi = bbi[pp * 16 + hi];
                const float wr_ = ar * br - ai * bi, wi_ = ar * bi + ai * br; s += ccr[ho * 64 + pp] * wr_ - cci[ho * 64 + pp] * wi_; }
            kt[id] = s; }
        __syncthreads();
        for (int id = tid; id < 512 * 80; id += NTHR) { const int n = id / 80, oc = id % 80, t = n >> 4, ho = n & 15; float f[8];
            if (oc < 64) { const int s = oc >> 1, hi0 = (oc & 1) * 8;
                for (int i = 0; i < 8; ++i) f[i] = (s <= t) ? kt[(t - s) * 256 + ho * 16 + hi0 + i] : 0.f;
            } else { for (int i = 0; i < 8; ++i) { const int cc = (oc - 64) * 8 + i, ri = cc >> 6, pp = cc & 63;
                const float ar = apr[(t + 1) * 64 + pp], ai = api[(t + 1) * 64 + pp], cr = ccr[ho * 64 + pp], ci = cci[ho * 64 + pp];
                f[i] = ri == 0 ? (cr * ar - ci * ai) : -(cr * ai + ci * ar); } }
            *(u32x4*)(bt2 + ((size_t)g * 512 + n) * 640 + oc * 8) = pack8(f); }
        for (int id = tid; id < 256 * 64; id += NTHR) { const int rr = id >> 6, oc = id & 63; float f[8];
            if (rr < 128) { const int ri = rr >> 6, pp = rr & 63, s = oc >> 1, hi0 = (oc & 1) * 8; const float ar = apr[(31 - s) * 64 + pp], ai = api[(31 - s) * 64 + pp];
                for (int i = 0; i < 8; ++i) { const float br = bbr[pp * 16 + hi0 + i], bi = bbi[pp * 16 + hi0 + i]; f[i] = ri == 0 ? (ar * br - ai * bi) : (ar * bi + ai * br); }
            } else { for (int i = 0; i < 8; ++i) f[i] = 0.f; }
            *(u32x4*)(m2 + ((size_t)g * 256 + rr) * 512 + oc * 8) = pack8(f); }
        __syncthreads();
    }
}

DI float wave_sum(float v) {
#pragma unroll
    for (int o = 32; o >= 1; o >>= 1) v += __shfl_xor(v, o);
    return v;
}
template <bool FIRST, bool SECOND>
DI void phase_ln(const float* src, const float* g, const float* b, float* dst1, const float* sh, const float* sc, bf16_t* dsth) {
    const int wid = TID() >> 6, lane = TID() & 63;
    for (int row = BID() * 8 + wid; row < L; row += GDIM() * 8) {
        float v[4][8];
#pragma unroll
        for (int i = 0; i < 4; ++i) { const f32x4 a = *(const f32x4*)(src + (size_t)row * DM + i * 512 + lane * 8), c = *(const f32x4*)(src + (size_t)row * DM + i * 512 + lane * 8 + 4);
            v[i][0] = a[0]; v[i][1] = a[1]; v[i][2] = a[2]; v[i][3] = a[3]; v[i][4] = c[0]; v[i][5] = c[1]; v[i][6] = c[2]; v[i][7] = c[3]; }
        if (FIRST) {
            float s = 0.f;
#pragma unroll
            for (int i = 0; i < 4; ++i) for (int k = 0; k < 8; ++k) s += v[i][k];
            const float mu = wave_sum(s) * (1.f / DM); float q = 0.f;
#pragma unroll
            for (int i = 0; i < 4; ++i) for (int k = 0; k < 8; ++k) { const float d = v[i][k] - mu; q += d * d; }
            const float rs = rsqrtf(wave_sum(q) * (1.f / DM) + 1e-5f);
#pragma unroll
            for (int i = 0; i < 4; ++i) { const int c0 = i * 512 + lane * 8;
                const f32x4 g0 = *(const f32x4*)(g + c0), g1 = *(const f32x4*)(g + c0 + 4), b0 = *(const f32x4*)(b + c0), b1 = *(const f32x4*)(b + c0 + 4);
                for (int k = 0; k < 4; ++k) { v[i][k] = (v[i][k] - mu) * rs * g0[k] + b0[k]; v[i][4 + k] = (v[i][4 + k] - mu) * rs * g1[k] + b1[k]; }
                *(f32x4*)(dst1 + (size_t)row * DM + c0) = (f32x4){v[i][0], v[i][1], v[i][2], v[i][3]};
                *(f32x4*)(dst1 + (size_t)row * DM + c0 + 4) = (f32x4){v[i][4], v[i][5], v[i][6], v[i][7]}; }
        }
        if (SECOND) {
            float s = 0.f;
#pragma unroll
            for (int i = 0; i < 4; ++i) for (int k = 0; k < 8; ++k) s += v[i][k];
            const float mu = wave_sum(s) * (1.f / DM); float q = 0.f;
#pragma unroll
            for (int i = 0; i < 4; ++i) for (int k = 0; k < 8; ++k) { const float d = v[i][k] - mu; q += d * d; }
            const float rs = rsqrtf(wave_sum(q) * (1.f / DM) + 1e-5f);
#pragma unroll
            for (int i = 0; i < 4; ++i) { const int c0 = i * 512 + lane * 8; float f[8];
                const f32x4 s0 = *(const f32x4*)(sc + c0), s1 = *(const f32x4*)(sc + c0 + 4), h0 = *(const f32x4*)(sh + c0), h1 = *(const f32x4*)(sh + c0 + 4);
                for (int k = 0; k < 4; ++k) { f[k] = (v[i][k] - mu) * rs * (1.f + s0[k]) + h0[k]; f[4 + k] = (v[i][4 + k] - mu) * rs * (1.f + s1[k]) + h1[k]; }
                *(u32x4*)(dsth + (size_t)row * DM + c0) = pack8(f); }
        }
    }
}

DI void phase_carry(PP p) {
    const int id = BID() * NTHR + TID();
    if (id >= 4096) return;
    const int g = id >> 6, pp = id & 63;
    const float* a32 = (const float*)(p->ws + O_A32); const float* xe = (const float*)(p->ws + O_XEND) + (size_t)g * 512 * 128 + pp;
    bf16_t* up = (bf16_t*)(p->ws + O_E) + (size_t)g * 512 * 640 + 512 + pp;
    const float ar = a32[id * 2], ai = a32[id * 2 + 1];
    float xr = 0.f, xi = 0.f;
#pragma unroll 8
    for (int c = 0; c < 512; ++c) {
        up[(size_t)c * 640] = f2bf(xr); up[(size_t)c * 640 + 64] = f2bf(xi);
        const float er = xe[(size_t)c * 128], ei = xe[(size_t)c * 128 + 64];
        const float nr = ar * xr - ai * xi + er, ni = ar * xi + ai * xr + ei; xr = nr; xi = ni;
    }
}

constexpr int QN_O = 0, KN_O = 17408, XTK_O = 34816, XTV_O = 53248, KT2_O = 71680, TIMG_O = 90112, MM_O = 99328, AT_O = 116736, SC_O = 134144;
DI void gdn_intra(LAS unsigned char* lds, PP p, int l, int item) {
    { unsigned lb = (unsigned)(size_t)lds; asm volatile("" : "+v"(lb)); lds = (LAS unsigned char*)lb; }
    const int tid = TID(), w = tid >> 6, lane = tid & 63, r = lane & 31, h = lane >> 5;
    const int hd = item >> 8, n = item & 255, tok0 = n * 64;
    LAS bf16_t* Qn = (LAS bf16_t*)(lds + QN_O); LAS bf16_t* Kn = (LAS bf16_t*)(lds + KN_O);
    LAS bf16_t* XTk = (LAS bf16_t*)(lds + XTK_O); LAS bf16_t* XTv = (LAS bf16_t*)(lds + XTV_O); LAS bf16_t* KT2 = (LAS bf16_t*)(lds + KT2_O);
    LAS bf16_t* Timg = (LAS bf16_t*)(lds + TIMG_O); LAS float* Mm = (LAS float*)(lds + MM_O); LAS float* At = (LAS float*)(lds + AT_O);
    LAS float* scb = (LAS float*)(lds + SC_O); LAS float* scg = scb + 64; LAS float* sce = scb + 128; LAS float* scl = scb + 192;
    const float* logit = (const float*)(p->ws + O_LOG);
    const bf16_t* qkv = (const bf16_t*)(p->ws + O_QKV);
    unsigned char* fb = p->ws + O_A + (size_t)item * FRAG_ITEM;
    unsigned char* ub = p->ws + O_UFR + (size_t)item * UFR_ITEM;
    if (tid < 64) {
        const int tok = tok0 + tid;
        const float bl = logit[(size_t)tok * 16 + hd], al = logit[(size_t)tok * 16 + 8 + hd];
        const float beta = 1.f / (1.f + expf(-bl));
        const float xx = al + p->in[17][l * 8 + hd];
        const float sp = xx > 20.f ? xx : log1pf(expf(xx));
        float gc = -expf(p->in[16][l * 8 + hd]) * sp;
#pragma unroll
        for (int off = 1; off < 64; off <<= 1) { const float t = __shfl_up(gc, off); if (tid >= off) gc += t; }
        const float gl = __shfl(gc, 63);
        scb[tid] = beta; scg[tid] = gc; sce[tid] = expf(gc); scl[tid] = expf(gl - gc);
        if (tid == 0) ((float*)(p->ws + O_GL))[hd * 256 + n] = expf(gl);
    }
    __syncthreads();
    const float* cw = p->in[15] + (size_t)l * 4 * 3072;
#pragma unroll 1
    for (int mat = 0; mat < 3; ++mat) {
#pragma unroll 1
        for (int it = 0; it < 2; ++it) {
            const int id = tid + NTHR * it, j = id >> 4, o = id & 15, col = mat * 1024 + hd * 128 + o * 8;
            float a[8];
#pragma unroll
            for (int i = 0; i < 8; ++i) a[i] = 0.f;
#pragma unroll
            for (int kk = 0; kk < 4; ++kk) { const int t = tok0 + j - 3 + kk;
                if (t >= 0) { float x[8]; unpack8(*(const u32x4*)(qkv + (size_t)t * 3072 + col), x);
                    const f32x4 w0 = *(const f32x4*)(cw + kk * 3072 + col), w1 = *(const f32x4*)(cw + kk * 3072 + col + 4);
                    for (int i = 0; i < 4; ++i) { a[i] += w0[i] * x[i]; a[4 + i] += w1[i] * x[4 + i]; } } }
#pragma unroll
            for (int i = 0; i < 8; ++i) a[i] = a[i] / (1.f + expf(-a[i]));
            if (mat < 2) {
                float ss = 0.f;
#pragma unroll
                for (int i = 0; i < 8; ++i) ss += a[i] * a[i];
                ss += __shfl_xor(ss, 1); ss += __shfl_xor(ss, 2); ss += __shfl_xor(ss, 4); ss += __shfl_xor(ss, 8);
                const float sc = rsqrtf(ss + 1e-6f) * (mat == 0 ? 0.08838834764831845f : 1.f);
#pragma unroll
                for (int i = 0; i < 8; ++i) a[i] *= sc;
            }
            if (mat == 0) {
                *(LAS u32x4*)(Qn + j * 136 + o * 8) = pack8(a);
                const float eg = sce[j]; const int ct = j >> 5, s = o >> 1, part = o & 1;
                unsigned char* q0 = fb + 16384 + ((size_t)((ct * 8 + s) * 64 + (j & 31))) * 16 + 8 * part;
                u32x2 lo, hi2; lo.x = pk2(a[0] * eg, a[1] * eg); lo.y = pk2(a[2] * eg, a[3] * eg); hi2.x = pk2(a[4] * eg, a[5] * eg); hi2.y = pk2(a[6] * eg, a[7] * eg);
                *(u32x2*)q0 = lo; *(u32x2*)(q0 + 32 * 16) = hi2;
            } else if (mat == 1) {
                *(LAS u32x4*)(Kn + j * 136 + o * 8) = pack8(a);
                const float f1 = scb[j] * sce[j], f2 = scl[j];
#pragma unroll
                for (int i = 0; i < 8; ++i) { XTk[(o * 8 + i) * 72 + j] = f2bf(a[i] * f1); KT2[(o * 8 + i) * 72 + j] = f2bf(a[i] * f2); }
            } else {
                const float f1 = scb[j];
#pragma unroll
                for (int i = 0; i < 8; ++i) XTv[(o * 8 + i) * 72 + j] = f2bf(a[i] * f1);
            }
        }
    }
    __syncthreads();
    {
        const int isq = w >> 2, it = (w & 3) >> 1, jt = w & 1;
        LAS bf16_t* Ai = isq ? Qn : Kn;
        f32x16 acc; for (int i = 0; i < 16; ++i) acc[i] = 0.f;
#pragma unroll
        for (int s = 0; s < 8; ++s) { const bf16x8 a = *(const LAS bf16x8*)(Ai + (32 * it + r) * 136 + 16 * s + 8 * h), b = *(const LAS bf16x8*)(Kn + (32 * jt + r) * 136 + 16 * s + 8 * h);
            acc = MFMA32(a, b, acc); }
        const int col = 32 * jt + r; const float gcc = scg[col];
#pragma unroll
        for (int i = 0; i < 16; ++i) { const int row = 32 * it + crow(i, h);
            if (isq) At[row * 68 + col] = (row >= col) ? acc[i] * expf(scg[row] - gcc) : 0.f;
            else Mm[row * 68 + col] = (row > col) ? scb[row] * acc[i] * expf(scg[row] - gcc) : 0.f; }
    }
    __syncthreads();
    if (w == 0) {
        float t[64]; const float lanef = (float)lane;
#pragma unroll
        for (int i = 0; i < 64; ++i) {
            float a0 = fmaxf(0.f, 1.f - fabsf(lanef - (float)i)), a1 = 0.f;
#pragma unroll
            for (int j4 = 0; j4 < (i + 3) / 4; ++j4) { const f32x4 mv = *(const LAS f32x4*)(Mm + i * 68 + j4 * 4);
#pragma unroll
                for (int jj = 0; jj < 4; ++jj) { const int j = j4 * 4 + jj; if (j < i) { if (jj & 1) a1 -= mv[jj] * t[j]; else a0 -= mv[jj] * t[j]; } } }
            t[i] = a0 + a1;
            if ((i & 3) == 3) asm volatile("" ::: "memory");
        }
#pragma unroll
        for (int i = 0; i < 64; ++i) Timg[i * 72 + lane] = f2bf(t[i]);
    } else {
        for (int id = tid - 64; id < 1536; id += 448) {
            const int ln = id & 63, rr = ln & 31, hh = ln >> 5;
            if (id < 1024) { const int f = id >> 6, dt = f >> 2, s = f & 3; const int d = 32 * dt + rr;
                const u32x2 lo = *(const LAS u32x2*)(KT2 + d * 72 + 16 * s + 4 * hh), hi2 = *(const LAS u32x2*)(KT2 + d * 72 + 16 * s + 8 + 4 * hh);
                *(u32x4*)(fb + 40960 + (size_t)(f * 64 + ln) * 16) = (u32x4){lo.x, lo.y, hi2.x, hi2.y};
            } else { const int f = (id - 1024) >> 6, ct = f >> 2, s = f & 3; const int row = 32 * ct + rr;
                const f32x4 lo = *(const LAS f32x4*)(At + row * 68 + 16 * s + 4 * hh), hi2 = *(const LAS f32x4*)(At + row * 68 + 16 * s + 8 + 4 * hh);
                *(u32x4*)(fb + 32768 + (size_t)(f * 64 + ln) * 16) = pack44(lo, hi2); }
        }
    }
    __syncthreads();
    {
        const int ct = w >> 2, et = w & 3;
        f32x16 acc; for (int i = 0; i < 16; ++i) acc[i] = 0.f;
#pragma unroll
        for (int s = 0; s < 4; ++s) { const bf16x8 a = *(const LAS bf16x8*)(Timg + (32 * ct + r) * 72 + 16 * s + 8 * h), b = *(const LAS bf16x8*)(XTv + (32 * et + r) * 72 + 16 * s + 8 * h);
            acc = MFMA32(a, b, acc); }
        float* ud = (float*)(ub + (size_t)(ct * 4 + et) * 4096 + lane * 64);
#pragma unroll
        for (int q = 0; q < 4; ++q) *(f32x4*)(ud + 4 * q) = (f32x4){acc[4 * q], acc[4 * q + 1], acc[4 * q + 2], acc[4 * q + 3]};
        const int dt = w >> 1, c2 = w & 1;
        f32x16 ac2; for (int i = 0; i < 16; ++i) ac2[i] = 0.f;
#pragma unroll
        for (int s = 0; s < 4; ++s) { const bf16x8 a = *(const LAS bf16x8*)(XTk + (32 * dt + r) * 72 + 16 * s + 8 * h), b = *(const LAS bf16x8*)(Timg + (32 * c2 + r) * 72 + 16 * s + 8 * h);
            ac2 = MFMA32(a, b, ac2); }
#pragma unroll
        for (int sp = 0; sp < 2; ++sp) { u32x4 wv; wv.x = pk2(ac2[8 * sp], ac2[8 * sp + 1]); wv.y = pk2(ac2[8 * sp + 2], ac2[8 * sp + 3]); wv.z = pk2(ac2[8 * sp + 4], ac2[8 * sp + 5]); wv.w = pk2(ac2[8 * sp + 6], ac2[8 * sp + 7]);
            *(u32x4*)(fb + (size_t)((c2 * 8 + 2 * dt + sp) * 64 + lane) * 16) = wv; }
    }
    __syncthreads();
}

DI void gdn_scan(LAS unsigned char* lds, PP p, int wg) {
    const int tid = TID(), w = tid >> 6, lane = tid & 63, r = lane & 31, h = lane >> 5;
    const int hd = wg >> 1, cb = wg & 1, rt = w >> 1, et = w & 1;
    LAS u32x4* Simg = (LAS u32x4*)lds;
    LAS u32x4* Vimg = (LAS u32x4*)(lds + 16384);
    f32x16 S; for (int i = 0; i < 16; ++i) S[i] = 0.f;
    Simg[((2 * rt) * 2 + et) * 64 + lane] = (u32x4){0u, 0u, 0u, 0u}; Simg[((2 * rt + 1) * 2 + et) * 64 + lane] = (u32x4){0u, 0u, 0u, 0u};
    __syncthreads();
    const unsigned char* fb = p->ws + O_A + (size_t)(hd * 256) * FRAG_ITEM;
    const unsigned char* ub = p->ws + O_UFR + (size_t)(hd * 256) * UFR_ITEM;
    const float* GL = (const float*)(p->ws + O_GL) + hd * 256;
    bf16_t* obf = (bf16_t*)(p->ws + O_OBF);
    const size_t a1off = (rt < 2 ? 0 : 16384) + (size_t)((rt & 1) * 8) * 1024 + lane * 16;
    const size_t ktoff = 40960 + (size_t)(rt * 4) * 1024 + lane * 16;
    const size_t atoff = 32768 + (size_t)((rt & 1) * 4) * 1024 + lane * 16;
    const size_t uoff = (size_t)((rt & 1) * 4 + 2 * cb + et) * 4096 + lane * 64;
    bf16x8 A1[8], KT[4], AT[4]; f32x4 U[4];
    for (int s = 0; s < 4; ++s) { AT[s] = (bf16x8){0,0,0,0,0,0,0,0}; U[s] = (f32x4){0.f,0.f,0.f,0.f}; }
#define SCAN_LOAD(A1_, KT_, AT_, U_, n_) do { const unsigned char* f_ = fb + (size_t)(n_) * FRAG_ITEM; \
        _Pragma("unroll") for (int s = 0; s < 8; ++s) A1_[s] = *(const bf16x8*)(f_ + a1off + s * 1024); \
        _Pragma("unroll") for (int s = 0; s < 4; ++s) KT_[s] = *(const bf16x8*)(f_ + ktoff + s * 1024); \
        if (rt >= 2) { _Pragma("unroll") for (int s = 0; s < 4; ++s) AT_[s] = *(const bf16x8*)(f_ + atoff + s * 1024); } \
        else { const float* u_ = (const float*)(ub + (size_t)(n_) * UFR_ITEM + uoff); _Pragma("unroll") for (int q = 0; q < 4; ++q) U_[q] = *(const f32x4*)(u_ + 4 * q); } } while (0)
    SCAN_LOAD(A1, KT, AT, U, 0);
    for (int n = 0; n < 256; ++n) {
        bf16x8 A1n[8], KTn[4], ATn[4]; f32x4 Un[4];
        for (int s = 0; s < 4; ++s) { ATn[s] = (bf16x8){0,0,0,0,0,0,0,0}; Un[s] = (f32x4){0.f,0.f,0.f,0.f}; }
        const int nn = n + 1 < 256 ? n + 1 : n;
        SCAN_LOAD(A1n, KTn, ATn, Un, nn);
        const float gl = GL[n];
        f32x16 acc; for (int i = 0; i < 16; ++i) acc[i] = 0.f;
#pragma unroll
        for (int s = 0; s < 8; ++s) { const bf16x8 b = __builtin_bit_cast(bf16x8, Simg[(s * 2 + et) * 64 + lane]); acc = MFMA32(A1[s], b, acc); }
        if (rt < 2) {
#pragma unroll
            for (int sp = 0; sp < 2; ++sp) { float v[8];
#pragma unroll
                for (int j = 0; j < 8; ++j) v[j] = U[(8 * sp + j) >> 2][(8 * sp + j) & 3] - acc[8 * sp + j];
                Vimg[((2 * rt + sp) * 2 + et) * 64 + lane] = pack8(v); }
        }
        __syncthreads();
#pragma unroll
        for (int i = 0; i < 16; ++i) S[i] *= gl;
#pragma unroll
        for (int s = 0; s < 4; ++s) { const bf16x8 b = __builtin_bit_cast(bf16x8, Vimg[(s * 2 + et) * 64 + lane]); S = MFMA32(KT[s], b, S); if (rt >= 2) acc = MFMA32(AT[s], b, acc); }
        if (rt >= 2) {
            const int col = hd * 128 + 64 * cb + 32 * et + r;
#pragma unroll
            for (int i = 0; i < 16; ++i) { const int tok = 64 * n + 32 * (rt - 2) + crow(i, h); obf[(size_t)tok * 1024 + col] = f2bf(acc[i]); }
        }
#pragma unroll
        for (int sp = 0; sp < 2; ++sp) { float v[8];
#pragma unroll
            for (int j = 0; j < 8; ++j) v[j] = S[8 * sp + j];
            Simg[((2 * rt + sp) * 2 + et) * 64 + lane] = pack8(v); }
        __syncthreads();
#pragma unroll
        for (int s = 0; s < 8; ++s) A1[s] = A1n[s];
#pragma unroll
        for (int s = 0; s < 4; ++s) { KT[s] = KTn[s]; AT[s] = ATn[s]; U[s] = Un[s]; }
    }
#undef SCAN_LOAD
}

DI void phase_normgate(PP p, int l, int nblk, int bid) {
    bf16_t* obf = (bf16_t*)(p->ws + O_OBF); const bf16_t* z = (const bf16_t*)(p->ws + O_Z);
    const int o8 = TID() & 15;
    const f32x4 w0 = *(const f32x4*)(p->in[18] + l * 128 + o8 * 8), w1 = *(const f32x4*)(p->in[18] + l * 128 + o8 * 8 + 4);
    for (int grp = bid * 32 + (TID() >> 4); grp < L * 8; grp += nblk * 32) {
        const size_t base = (size_t)(grp >> 3) * 1024 + (grp & 7) * 128 + o8 * 8;
        float o[8], zz[8]; unpack8(*(const u32x4*)(obf + base), o); unpack8(*(const u32x4*)(z + base), zz);
        float ss = 0.f;
#pragma unroll
        for (int i = 0; i < 8; ++i) ss += o[i] * o[i];
        ss += __shfl_xor(ss, 1); ss += __shfl_xor(ss, 2); ss += __shfl_xor(ss, 4); ss += __shfl_xor(ss, 8);
        const float sc = rsqrtf(ss * (1.f / 128.f) + 1e-6f);
#pragma unroll
        for (int i = 0; i < 4; ++i) { o[i] = o[i] * sc * w0[i] * siluf_(zz[i]); o[4 + i] = o[4 + i] * sc * w1[i] * siluf_(zz[4 + i]); }
        *(u32x4*)(obf + base) = pack8(o);
    }
}

__global__ void __launch_bounds__(512, 2) hybrid_fwd(Params p_arg) {
    extern __shared__ __attribute__((aligned(16))) unsigned char shm[];
    LAS unsigned char* lds = (LAS unsigned char*)shm;
    cg::grid_group grid = cg::this_grid();
    using namespace pg8;

    for (int st = 0; st < 26; ++st) {
        const int l = st < 2 ? 0 : (st - 2) / 12;
        const int ph = st < 2 ? st : 2 + (st - 2) % 12;
        PP p = (PP)__builtin_amdgcn_kernarg_segment_ptr();
        asm volatile("" : "+s"(p));
        const int G = GDIM(), bid = BID();
        unsigned char* ws = p->ws;
        float* mod = (float*)(ws + O_MOD);
        bf16_t* hbuf = (bf16_t*)(ws + O_D);
        float* vbuf = (float*)(ws + O_B);
        const float* ml = mod + l * 12288;
        switch (ph) {
        case 0:
            phase_mod(lds, p); phase_weights(lds, p, 0); phase_s5pre(lds, p, 0);
            break;
        case 1:
            phase_ln<false, true>(p->in[0], nullptr, nullptr, nullptr, mod + 0, mod + 2048, hbuf);
            break;
        case 2: {
            Gemm g{hbuf, (const bf16_t*)(ws + O_WIN), DM, DM, DM}; StaticOrder S; S.init(L, NPROJ, G, bid);
            EpiProj E{(bf16_t*)(ws + O_E), (bf16_t*)(ws + O_QKV), (bf16_t*)(ws + O_Z), (bf16_t*)(ws + O_SGS), (bf16_t*)(ws + O_SGG), (float*)(ws + O_LOG)};
            gemm_phase(lds, g, S, E); } break;
        case 3: {
            { Gemm g{(const bf16_t*)(ws + O_E), (const bf16_t*)(ws + O_M2), 640, 512, 512}; OrderS5X S{G, bid}; EpiXend E{(float*)(ws + O_XEND)};
              gemm_phase(lds, g, S, E); }
            __syncthreads();
            for (int item = bid; item < 2048; item += G) gdn_intra(lds, p, l, item); } break;
        case 4:
            phase_carry(p);
            break;
        case 5:
            if (bid < 16) gdn_scan(lds, p, bid);
            else { Gemm g{(const bf16_t*)(ws + O_E), (const bf16_t*)(ws + O_BT2), 640, 640, 640}; OrderS5Y S{G - 16, bid - 16};
                   EpiS5Y E{(const bf16_t*)(ws + O_E), p->in[12] + l * 1024, (bf16_t*)(ws + O_ZS)}; gemm_phase(lds, g, S, E); }
            break;
        case 6: {
            phase_normgate(p, l, G, bid);
            Gemm g{(const bf16_t*)(ws + O_ZS), (const bf16_t*)(ws + O_WGLU), 1024, 1024, 1024}; StaticOrder S; S.init(L, 1024, G, bid);
            EpiGlu E{(const bf16_t*)(ws + O_ZS), p->in[14] + l * 1024, (bf16_t*)(ws + O_Y2)}; gemm_phase(lds, g, S, E); } break;
        case 7: {
            Gemm g{(const bf16_t*)(ws + O_Y2), (const bf16_t*)(ws + O_WUPS), 1024, 1024, 1024}; StaticOrder S; S.init(L, 2048, G, bid);
            EpiUp<0> E{(const bf16_t*)(ws + O_SGS), nullptr, (bf16_t*)(ws + O_T1)}; gemm_phase(lds, g, S, E); } break;
        case 8: {
            Gemm g{(const bf16_t*)(ws + O_OBF), (const bf16_t*)(ws + O_WUPG), 1024, 1024, 1024}; StaticOrder S; S.init(L, 2048, G, bid);
            EpiUp<1> E{(const bf16_t*)(ws + O_SGG), (const bf16_t*)(ws + O_T1), (bf16_t*)(ws + O_MRG)}; gemm_phase(lds, g, S, E); } break;
        case 9: {
            const float* xin = l == 0 ? p->in[0] : p->out;
            Gemm g{(const bf16_t*)(ws + O_MRG), (const bf16_t*)(ws + O_WOUT), DM, DM, DM}; StaticOrder S; S.init(L, DM, G, bid);
            EpiResid E{xin, ml + 4096, vbuf}; gemm_phase(lds, g, S, E); } break;
        case 10:
            phase_ln<true, true>(vbuf, p->in[22] + l * DM, p->in[23] + l * DM, vbuf, ml + 6144, ml + 8192, hbuf);
            break;
        case 11: {
            Gemm g{hbuf, (const bf16_t*)(ws + O_WF1), DM, DM, DM}; StaticOrder S; S.init(L, 2 * FH, G, bid);
            EpiSwiglu E{(bf16_t*)(ws + O_A)}; gemm_phase(lds, g, S, E); } break;
        case 12: {
            Gemm g{(const bf16_t*)(ws + O_A), (const bf16_t*)(ws + O_WF2), FH, FH, FH}; StaticOrder S; S.init(L, DM, G, bid);
            EpiResid E{vbuf, ml + 10240, vbuf}; gemm_phase(lds, g, S, E); } break;
        default:
            if (l == 0) {
                phase_ln<true, true>(vbuf, p->in[26], p->in[27], p->out, mod + 12288, mod + 12288 + 2048, hbuf);
                __syncthreads();
                phase_weights(lds, p, 1);
                phase_s5pre(lds, p, 1);
            } else {
                phase_ln<true, false>(vbuf, p->in[26] + DM, p->in[27] + DM, p->out, nullptr, nullptr, nullptr);
            }
            break;
        }
        if (st != 25) grid.sync();
    }
}

extern "C" void kernel_launch(void* const* d_in, const int* in_sizes, int n_in, void* d_out, int out_size, void* d_ws, size_t ws_size, hipStream_t stream) {
    static int grid_blocks = 0;
    if (grid_blocks == 0) {
        if (n_in != 28 || ws_size < WS_END) { fprintf(stderr, "kernel_launch: need 28 inputs and %zu bytes of workspace; got %d, %zu\n", (size_t)WS_END, n_in, ws_size); grid_blocks = -1; return; }
        int dev = 0, cus = 0, per_cu = 0;
        hipGetDevice(&dev);
        hipDeviceGetAttribute(&cus, hipDeviceAttributeMultiprocessorCount, dev);
        if (hipFuncSetAttribute((const void*)hybrid_fwd, hipFuncAttributeMaxDynamicSharedMemorySize, LDS_BYTES) != hipSuccess) { fprintf(stderr, "kernel_launch: hipFuncSetAttribute failed\n"); grid_blocks = -1; return; }
        hipOccupancyMaxActiveBlocksPerMultiprocessor(&per_cu, (const void*)hybrid_fwd, NTHR, LDS_BYTES);
        if (per_cu < 1) { fprintf(stderr, "kernel_launch: occupancy query says %d blocks per CU\n", per_cu); per_cu = 1; }
        (void)hipGetLastError();
        grid_blocks = cus;
    }
    if (grid_blocks < 0) return;
    Params p{};
    for (int i = 0; i < 28; ++i) p.in[i] = (const float*)d_in[i];
    p.out = (float*)d_out; p.ws = (unsigned char*)d_ws;
    void* args[] = {&p};
    hipError_t e = hipLaunchCooperativeKernel((const void*)hybrid_fwd, dim3(grid_blocks), dim3(NTHR), args, LDS_BYTES, stream);
    if (e != hipSuccess) fprintf(stderr, "cooperative launch failed: %s (grid %d)\n", hipGetErrorString(e), grid_blocks);
}
```

```cpp
#include <hip/hip_runtime.h>
#include <hip/hip_cooperative_groups.h>
#include <cstdio>
namespace cg = cooperative_groups;

#define LAS __attribute__((address_space(3)))
#define DI __device__ __forceinline__
typedef unsigned short bf16_t;
typedef short bf16x8 __attribute__((ext_vector_type(8)));
typedef float f32x2 __attribute__((ext_vector_type(2)));
typedef float f32x4 __attribute__((ext_vector_type(4)));
typedef float f32x16 __attribute__((ext_vector_type(16)));
typedef unsigned u32x4 __attribute__((ext_vector_type(4)));
typedef unsigned u32x2 __attribute__((ext_vector_type(2)));
typedef __bf16 bf2_t __attribute__((ext_vector_type(2)));

constexpr int L = 16384, DM = 2048, NPROJ = 9472, FH = 5632, NTHR = 512;
constexpr float ALPHA = 1.41421356237f;
constexpr int LDS_BYTES = 143360;

constexpr size_t SZ_WIN = (size_t)NPROJ * DM * 2, SZ_WGLU = 1024ull * 1024 * 2, SZ_WUP = 2048ull * 1024 * 2, SZ_WOUT = 2048ull * 2048 * 2,
                 SZ_WF1 = 11264ull * 2048 * 2, SZ_WF2 = 2048ull * 5632 * 2;
constexpr size_t O_WIN = 0, O_WGLU = O_WIN + SZ_WIN, O_WUPS = O_WGLU + SZ_WGLU, O_WUPG = O_WUPS + SZ_WUP, O_WOUT = O_WUPG + SZ_WUP,
                 O_WF1 = O_WOUT + SZ_WOUT, O_WF2 = O_WF1 + SZ_WF1;
constexpr size_t SZ_BT2 = 64ull * 512 * 640 * 2, SZ_M2 = 64ull * 256 * 512 * 2;
constexpr size_t O_BT2 = O_WF2 + SZ_WF2, O_M2 = O_BT2 + SZ_BT2;
constexpr size_t SZ_A = (size_t)L * FH * 2;
constexpr size_t O_A = O_M2 + SZ_M2;
constexpr size_t FRAG_ITEM = 57344, UFR_ITEM = 32768;
constexpr size_t O_UFR = O_A + 2048 * FRAG_ITEM;
constexpr size_t O_Y2 = O_A, O_T1 = O_A + (size_t)L * 1024 * 2, O_MRG = O_T1 + (size_t)L * 2048 * 2;
constexpr size_t SZ_B = (size_t)L * DM * 4;
constexpr size_t O_B = O_A + SZ_A, O_QKV = O_B, O_Z = O_B + (size_t)L * 3072 * 2;
constexpr size_t O_C = O_B + SZ_B, O_SGS = O_C, O_SGG = O_C + (size_t)L * 2048 * 2;
constexpr size_t O_D = O_C + 2 * (size_t)L * 2048 * 2;
constexpr size_t O_ZS = O_D, O_OBF = O_D + (size_t)L * 1024 * 2;
constexpr size_t O_E = O_D + (size_t)L * 2048 * 2;
constexpr size_t O_LOG = O_E + 64ull * 512 * 640 * 2;
constexpr size_t O_XEND = O_LOG + (size_t)L * 16 * 4;
constexpr size_t O_MOD = O_XEND + 64ull * 512 * 128 * 4;
constexpr size_t O_A32 = O_MOD + 2 * 12288 * 4;
constexpr size_t O_GL = O_A32 + 64 * 64 * 2 * 4;
constexpr size_t O_BAR = O_GL + 8 * 256 * 4;
constexpr size_t WS_END = O_BAR + 256;

struct Params {
    const float* in[28];
    float* out;
    unsigned char* ws;
};

extern "C" __device__ size_t __ockl_get_num_groups(unsigned);
typedef const __attribute__((address_space(4))) Params* PP;
DI int TID() { int t = __builtin_amdgcn_workitem_id_x(); asm volatile("" : "+v"(t)); return t; }
DI int GDIM() { return (int)__ockl_get_num_groups(0); }
DI int BID() { int t = __builtin_amdgcn_workgroup_id_x(); asm volatile("" : "+s"(t)); return t; }
DI unsigned pk2(float lo, float hi) { f32x2 v = {lo, hi}; bf2_t b = __builtin_convertvector(v, bf2_t); return __builtin_bit_cast(unsigned, b); }
DI bf16_t f2bf(float f) { return (bf16_t)(pk2(f, 0.f) & 0xffffu); }
DI float bflo(unsigned w) { return __uint_as_float(w << 16); }
DI float bfhi(unsigned w) { return __uint_as_float(w & 0xffff0000u); }
DI void unpack8(u32x4 w, float* f) { f[0] = bflo(w.x); f[1] = bfhi(w.x); f[2] = bflo(w.y); f[3] = bfhi(w.y); f[4] = bflo(w.z); f[5] = bfhi(w.z); f[6] = bflo(w.w); f[7] = bfhi(w.w); }
DI u32x4 pack8(const float* f) { u32x4 w; w.x = pk2(f[0], f[1]); w.y = pk2(f[2], f[3]); w.z = pk2(f[4], f[5]); w.w = pk2(f[6], f[7]); return w; }
DI u32x4 pack44(f32x4 a, f32x4 b) { u32x4 w; w.x = pk2(a[0], a[1]); w.y = pk2(a[2], a[3]); w.z = pk2(b[0], b[1]); w.w = pk2(b[2], b[3]); return w; }
DI float sigmoidf_(float x) { return 1.f / (1.f + __expf(-x)); }
DI float siluf_(float x) { return x / (1.f + __expf(-x)); }
DI float gelu_tanh(float y) { float t = 0.7978845608f * (y + 0.044715f * y * y * y); float e = __expf(2.f * t); return 0.5f * y * (2.f - 2.f / (e + 1.f)); }
DI void lds_barrier() { asm volatile("s_waitcnt lgkmcnt(0)" ::: "memory"); __builtin_amdgcn_s_barrier(); asm volatile("" ::: "memory"); }
DI void gbar(unsigned* cnt, unsigned target) {
    asm volatile("s_waitcnt vmcnt(0) lgkmcnt(0)" ::: "memory");
    __builtin_amdgcn_s_barrier();
    if (__builtin_amdgcn_workitem_id_x() == 0) {
        __builtin_amdgcn_fence(__ATOMIC_RELEASE, "agent");
        asm volatile("s_waitcnt vmcnt(0) lgkmcnt(0)" ::: "memory");
        __hip_atomic_fetch_add(cnt, 1u, __ATOMIC_RELAXED, __HIP_MEMORY_SCOPE_AGENT);
        while (__hip_atomic_load(cnt, __ATOMIC_RELAXED, __HIP_MEMORY_SCOPE_AGENT) < target) __builtin_amdgcn_s_sleep(2);
    }
    asm volatile("" ::: "memory");
    __builtin_amdgcn_s_barrier();
    __builtin_amdgcn_fence(__ATOMIC_ACQUIRE, "agent");
    asm volatile("s_waitcnt vmcnt(0)" ::: "memory");
}
DI int crow(int reg, int h) { return (reg & 3) + 8 * (reg >> 2) + 4 * h; }
#define MFMA32(a, b, c) __builtin_amdgcn_mfma_f32_32x32x16_bf16((a), (b), (c), 0, 0, 0)

namespace pg8 {
constexpr int BM = 256, BK = 64, HALF = 128, HTB = HALF * BK * 2, STAGE_BYTES = 8 * HTB, NXCD = 8, WGM = 8;
DI int lds_byte(int r, int c) { const int st = (r >> 4) * 2 + (c >> 5), rr = r & 15, cc = c & 31, ob = rr * 64 + cc * 2; return st * 1024 + (ob ^ (((ob >> 9) & 1) << 5)); }
DI void stage_rc(int b, int& R, int& C) { const int st = b / 1024, sb = b % 1024, swz = sb ^ (((sb >> 9) & 1) << 5); R = (st >> 1) * 16 + swz / 64; C = (st & 1) * 32 + (swz % 64) / 2; }
DI int perm32(int rho) { const int n = rho >> 4, i = rho & 15; return 8 * (i >> 2) + 4 * n + (i & 3); }
struct Unit { int pm, pn; };
struct Gemm { const bf16_t* A; const bf16_t* Bt; int lda, ldb, K; };

struct StaticOrder {
    int nM, nN, nwg, G, c;
    DI void init(int M, int N, int G_, int c_) { nM = M / BM; nN = N / BM; nwg = nM * nN; G = G_; c = c_; }
    DI bool next(int i, Unit& u) const {
        const long Li = (long)i * G + c; if (c < 0 || Li >= nwg) return false;
        int wgid = (int)Li; { const int q = nwg / NXCD, r = nwg % NXCD, xcd = wgid % NXCD, off = wgid / NXCD; wgid = (xcd < r ? xcd * (q + 1) : r * (q + 1) + (xcd - r) * q) + off; }
        const int nig = WGM * nN, gid = wgid / nig, fm = gid * WGM, gsz = (nM - fm) < WGM ? (nM - fm) : WGM;
        u.pm = fm + ((wgid % nig) % gsz); u.pn = (wgid % nig) / gsz; return true;
    }
};
struct OrderS5Y { int G, c; DI bool next(int i, Unit& u) const { const int Li = i * G + c; if (c < 0 || Li >= 256) return false; const int g = Li >> 2; u.pm = 2 * g + ((Li >> 1) & 1); u.pn = 2 * g + (Li & 1); return true; } };
struct OrderS5X { int G, c; DI bool next(int i, Unit& u) const { const int Li = i * G + c; if (c < 0 || Li >= 128) return false; const int g = Li >> 1; u.pm = 2 * g + (Li & 1); u.pn = g; return true; } };

template <class Epi, class Sched>
DI void gemm_phase(LAS unsigned char* lds, const Gemm g, const Sched& S, const Epi& E) {
    const int tid = TID(), wid = __builtin_amdgcn_readfirstlane(tid >> 6), lane = tid & 63, wr = wid >> 2, wc = wid & 3, fr = lane & 15, fq = lane >> 4;
    const int K = g.K, nt = K / BK;
    unsigned voffA[2], voffB[2];
#pragma unroll
    for (int i = 0; i < 2; ++i) { int R, C; stage_rc(tid * 16 + i * 8192, R, C); const int Rb = Epi::PERM ? ((R & ~31) + perm32(R & 31)) : R;
        voffA[i] = (unsigned)(R * g.lda + C) * 2u; voffB[i] = (unsigned)(Rb * g.ldb + C) * 2u; }
    const size_t kstep = (size_t)(BK * 2);
    const size_t hstepA = (size_t)HALF * g.lda * 2, hstepB = (size_t)HALF * g.ldb * 2;
    const size_t tstepA = 2 * hstepA, tstepB = 2 * hstepB;
    const unsigned ldsw = (unsigned)wid * 1024u;
    const int aoff = lds_byte(wr * 64 + fr, fq * 8), boff = lds_byte(wc * 32 + fr, fq * 8);
#define PG8_SA(b, h) (((b) * 2 + (h)) * HTB)
#define PG8_SB(b, h) ((4 + (b) * 2 + (h)) * HTB)
#define PG8_STAGE(bufoff, gbase, voff) do { _Pragma("unroll") for (int _i = 0; _i < 2; ++_i) \
        __builtin_amdgcn_global_load_lds((const unsigned*)((const char*)(gbase) + (voff)[_i]), (LAS unsigned*)(lds + (bufoff) + ldsw + _i * 8192), 16, 0, 0); } while (0)
#define PG8_LDA(dst, b, h) do { _Pragma("unroll") for (int m = 0; m < 4; ++m) _Pragma("unroll") for (int k = 0; k < 2; ++k) dst[m][k] = *(const LAS bf16x8*)(lds + PG8_SA(b, h) + aoff + m * 2048 + k * 1024); } while (0)
#define PG8_LDB(dst, b, h) do { _Pragma("unroll") for (int n = 0; n < 2; ++n) _Pragma("unroll") for (int k = 0; k < 2; ++k) dst[n][k] = *(const LAS bf16x8*)(lds + PG8_SB(b, h) + boff + n * 2048 + k * 1024); } while (0)
#define PG8_MMA(ai, bj, At, Bt) do { __builtin_amdgcn_s_setprio(1); _Pragma("unroll") for (int m = 0; m < 4; ++m) _Pragma("unroll") for (int n = 0; n < 2; ++n) _Pragma("unroll") for (int k = 0; k < 2; ++k) \
        acc[ai][bj][m][n] = __builtin_amdgcn_mfma_f32_16x16x32_bf16(Bt[n][k], At[m][k], acc[ai][bj][m][n], 0, 0, 0); __builtin_amdgcn_s_setprio(0); } while (0)
#define PG8_WAIT_V(n) asm volatile("s_waitcnt vmcnt(" #n ")" ::: "memory")
#define PG8_WAIT_L(n) asm volatile("s_waitcnt lgkmcnt(" #n ")" ::: "memory")
#define PG8_BAR __builtin_amdgcn_s_barrier()
#define PG8_SCHED __builtin_amdgcn_sched_barrier(0)
    Unit cur, nxt; int ui = 0;
    if (!S.next(0, cur)) return;
    f32x4 acc[2][2][4][2];
#pragma unroll
    for (int a = 0; a < 2; ++a)
#pragma unroll
        for (int b = 0; b < 2; ++b)
#pragma unroll
            for (int m = 0; m < 4; ++m)
#pragma unroll
                for (int n = 0; n < 2; ++n) acc[a][b][m][n] = (f32x4){0.f, 0.f, 0.f, 0.f};
    bf16x8 At[4][2], B0[2][2], B1[2][2];
    const char* cA = (const char*)g.A + (size_t)cur.pm * tstepA; const char* cB = (const char*)g.Bt + (size_t)cur.pn * tstepB;
    PG8_STAGE(PG8_SB(0, 0), cB, voffB); PG8_STAGE(PG8_SA(0, 0), cA, voffA); PG8_STAGE(PG8_SB(0, 1), cB + hstepB, voffB); PG8_STAGE(PG8_SA(0, 1), cA + hstepA, voffA);
    if (wr == 1) PG8_BAR;
    PG8_WAIT_V(4); PG8_BAR;
    PG8_STAGE(PG8_SB(1, 0), cB + kstep, voffB); PG8_STAGE(PG8_SA(1, 0), cA + kstep, voffA); PG8_STAGE(PG8_SB(1, 1), cB + hstepB + kstep, voffB);
    PG8_WAIT_V(6); PG8_BAR;
    for (;;) {
        const bool has_next = S.next(ui + 1, nxt);
        const char* nA = has_next ? (const char*)g.A + (size_t)nxt.pm * tstepA : cA; const char* nB = has_next ? (const char*)g.Bt + (size_t)nxt.pn * tstepB : cB;
        for (int t = 0; t < nt; t += 2) {
            const bool last = (t == nt - 2);
            const char* a1 = cA + (size_t)(t + 1) * kstep;
            const char* a2 = last ? nA : cA + (size_t)(t + 2) * kstep; const char* b2 = last ? nB : cB + (size_t)(t + 2) * kstep;
            const char* a3 = a2 + kstep; const char* b3 = b2 + kstep;
            PG8_LDB(B0, 0, 0); PG8_SCHED; PG8_LDA(At, 0, 0); PG8_STAGE(PG8_SA(1, 1), a1 + hstepA, voffA);
            PG8_WAIT_L(8); PG8_BAR; PG8_WAIT_L(0); PG8_MMA(0, 0, At, B0); PG8_BAR; PG8_SCHED;
            PG8_LDB(B1, 0, 1); PG8_STAGE(PG8_SB(0, 0), b2, voffB);
            PG8_BAR; PG8_WAIT_L(0); PG8_MMA(0, 1, At, B1); PG8_BAR;
            PG8_LDA(At, 0, 1); PG8_STAGE(PG8_SA(0, 0), a2, voffA);
            PG8_BAR; PG8_WAIT_L(0); PG8_MMA(1, 0, At, B0); PG8_BAR; PG8_SCHED;
            PG8_STAGE(PG8_SB(0, 1), b2 + hstepB, voffB);
            PG8_WAIT_V(6); PG8_BAR; PG8_MMA(1, 1, At, B1); PG8_BAR;
            PG8_LDB(B0, 1, 0); PG8_SCHED; PG8_LDA(At, 1, 0); PG8_STAGE(PG8_SA(0, 1), a2 + hstepA, voffA);
            PG8_WAIT_L(8); PG8_BAR; PG8_WAIT_L(0); PG8_MMA(0, 0, At, B0); PG8_BAR; PG8_SCHED;
            PG8_LDB(B1, 1, 1); PG8_STAGE(PG8_SB(1, 0), b3, voffB);
            PG8_BAR; PG8_WAIT_L(0); PG8_MMA(0, 1, At, B1); PG8_BAR;
            PG8_LDA(At, 1, 1); PG8_STAGE(PG8_SA(1, 0), a3, voffA);
            PG8_BAR; PG8_WAIT_L(0); PG8_MMA(1, 0, At, B0); PG8_BAR; PG8_SCHED;
            PG8_STAGE(PG8_SB(1, 1), b3 + hstepB, voffB);
            PG8_WAIT_V(6); PG8_BAR; PG8_MMA(1, 1, At, B1); PG8_BAR;
        }
        E(acc, cur, wr, wc, fr, fq);
        if (!has_next) break;
#pragma unroll
        for (int a = 0; a < 2; ++a)
#pragma unroll
            for (int b = 0; b < 2; ++b)
#pragma unroll
                for (int m = 0; m < 4; ++m)
#pragma unroll
                    for (int n = 0; n < 2; ++n) acc[a][b][m][n] = (f32x4){0.f, 0.f, 0.f, 0.f};
        cur = nxt; cA = nA; cB = nB; ++ui;
    }
    PG8_WAIT_V(0);
    if (wr == 0) PG8_BAR;
    PG8_BAR;
#undef PG8_SA
#undef PG8_SB
#undef PG8_STAGE
#undef PG8_LDA
#undef PG8_LDB
#undef PG8_MMA
#undef PG8_WAIT_V
#undef PG8_WAIT_L
#undef PG8_BAR
#undef PG8_SCHED
}

typedef f32x4 Acc[2][2][4][2];
#define EPI_LOOP_PERM(...) _Pragma("unroll") for (int ai = 0; ai < 2; ++ai) _Pragma("unroll") for (int m = 0; m < 4; ++m) { const int row = u.pm * 256 + ai * 128 + wr * 64 + m * 16 + fr; \
    _Pragma("unroll") for (int bj = 0; bj < 2; ++bj) { const int c8 = bj * 128 + wc * 32 + 8 * fq; f32x4 v0 = acc[ai][bj][m][0], v1 = acc[ai][bj][m][1]; __VA_ARGS__ } }

struct EpiProj {
    static constexpr bool PERM = true;
    bf16_t *uperm, *qkv, *z, *sgs, *sgg; float* logit;
    DI void operator()(const Acc& acc, const Unit& u, int wr, int wc, int fr, int fq) const {
        const int pn = u.pn;
        if (pn < 4) {
            EPI_LOOP_PERM({ const int ch = pn * 256 + c8; *(u32x4*)(uperm + ((size_t)((ch >> 4) * 512 + (row >> 5)) * 640 + (row & 31) * 16 + (ch & 15))) = pack44(v0, v1); })
        } else if (pn < 16) {
            EPI_LOOP_PERM({ *(u32x4*)(qkv + (size_t)row * 3072 + (pn - 4) * 256 + c8) = pack44(v0, v1); })
        } else if (pn < 20) {
            EPI_LOOP_PERM({ *(u32x4*)(z + (size_t)row * 1024 + (pn - 16) * 256 + c8) = pack44(v0, v1); })
        } else if (pn < 36) {
            bf16_t* dst = pn < 28 ? sgs + (pn - 20) * 256 : sgg + (pn - 28) * 256;
            EPI_LOOP_PERM({ for (int j = 0; j < 4; ++j) { v0[j] = sigmoidf_(v0[j]); v1[j] = sigmoidf_(v1[j]); } *(u32x4*)(dst + (size_t)row * 2048 + c8) = pack44(v0, v1); })
        } else {
            EPI_LOOP_PERM({ if (bj == 0 && wc == 0 && fq < 2) { *(f32x4*)(logit + (size_t)row * 16 + 8 * fq) = v0; *(f32x4*)(logit + (size_t)row * 16 + 8 * fq + 4) = v1; } })
        }
    }
};
struct EpiXend {
    static constexpr bool PERM = false;
    float* xend;
    DI void operator()(const Acc& acc, const Unit& u, int wr, int wc, int fr, int fq) const {
#pragma unroll
        for (int ai = 0; ai < 2; ++ai)
#pragma unroll
            for (int m = 0; m < 4; ++m) { const int row = u.pm * 256 + ai * 128 + wr * 64 + m * 16 + fr;
#pragma unroll
                for (int n = 0; n < 2; ++n) *(f32x4*)(xend + (size_t)row * 128 + wc * 32 + 16 * n + 4 * fq) = acc[ai][0][m][n]; }
    }
};
struct EpiS5Y {
    static constexpr bool PERM = true;
    const bf16_t* uperm; const float* dskip; bf16_t* zs;
    DI void operator()(const Acc& acc, const Unit& u, int wr, int wc, int fr, int fq) const {
        const int g = u.pm >> 1, mt = u.pm & 1, nt = u.pn & 1;
#pragma unroll
        for (int ai = 0; ai < 2; ++ai)
#pragma unroll
            for (int m = 0; m < 4; ++m) { const int chunk = mt * 256 + ai * 128 + wr * 64 + m * 16 + fr;
#pragma unroll
                for (int bj = 0; bj < 2; ++bj) { const int n0 = nt * 256 + bj * 128 + wc * 32 + 8 * fq; const int t = n0 >> 4, ho0 = n0 & 15;
                    f32x4 v0 = acc[ai][bj][m][0], v1 = acc[ai][bj][m][1];
                    float uf[8]; unpack8(*(const u32x4*)(uperm + (size_t)(g * 512 + chunk) * 640 + n0), uf);
                    const f32x4 d0 = *(const f32x4*)(dskip + g * 16 + ho0), d1 = *(const f32x4*)(dskip + g * 16 + ho0 + 4);
                    for (int j = 0; j < 4; ++j) { v0[j] = gelu_tanh(v0[j] + d0[j] * uf[j]); v1[j] = gelu_tanh(v1[j] + d1[j] * uf[4 + j]); }
                    *(u32x4*)(zs + (size_t)(chunk * 32 + t) * 1024 + g * 16 + ho0) = pack44(v0, v1); } }
    }
};
struct EpiGlu {
    static constexpr bool PERM = true;
    const bf16_t* zs; const float* bias; bf16_t* y2;
    DI void operator()(const Acc& acc, const Unit& u, int wr, int wc, int fr, int fq) const {
        EPI_LOOP_PERM({ const int col = u.pn * 256 + c8; float zf[8]; unpack8(*(const u32x4*)(zs + (size_t)row * 1024 + col), zf);
            const f32x4 b0 = *(const f32x4*)(bias + col), b1 = *(const f32x4*)(bias + col + 4);
            for (int j = 0; j < 4; ++j) { v0[j] = zf[j] * sigmoidf_(v0[j] + b0[j]); v1[j] = zf[4 + j] * sigmoidf_(v1[j] + b1[j]); }
            *(u32x4*)(y2 + (size_t)row * 1024 + col) = pack44(v0, v1); })
    }
};
template <int SECOND> struct EpiUp {
    static constexpr bool PERM = true;
    const bf16_t* gate; const bf16_t* t1in; bf16_t* dst;
    DI void operator()(const Acc& acc, const Unit& u, int wr, int wc, int fr, int fq) const {
        EPI_LOOP_PERM({ const size_t o = (size_t)row * 2048 + u.pn * 256 + c8; float gf[8]; unpack8(*(const u32x4*)(gate + o), gf);
            float tf[8]; if (SECOND) unpack8(*(const u32x4*)(t1in + o), tf); else { for (int j = 0; j < 8; ++j) tf[j] = 0.f; }
            for (int j = 0; j < 4; ++j) { v0[j] = tf[j] + gf[j] * v0[j]; v1[j] = tf[4 + j] + gf[4 + j] * v1[j]; }
            *(u32x4*)(dst + o) = pack44(v0, v1); })
    }
};
struct EpiResid {
    static constexpr bool PERM = false;
    const float* xin; const float* gate; float* out;
    DI void operator()(const Acc& acc, const Unit& u, int wr, int wc, int fr, int fq) const {
#pragma unroll
        for (int ai = 0; ai < 2; ++ai)
#pragma unroll
            for (int m = 0; m < 4; ++m) { const int row = u.pm * 256 + ai * 128 + wr * 64 + m * 16 + fr;
#pragma unroll
                for (int bj = 0; bj < 2; ++bj)
#pragma unroll
                    for (int n = 0; n < 2; ++n) { const int col = u.pn * 256 + bj * 128 + wc * 32 + 16 * n + 4 * fq; const size_t o = (size_t)row * 2048 + col;
                        const f32x4 xv = *(const f32x4*)(xin + o), gv = *(const f32x4*)(gate + col);
                        *(f32x4*)(out + o) = ALPHA * xv + gv * acc[ai][bj][m][n]; } }
    }
};
struct EpiSwiglu {
    static constexpr bool PERM = true;
    bf16_t* a;
    DI void operator()(const Acc& acc, const Unit& u, int wr, int wc, int fr, int fq) const {
#pragma unroll
        for (int ai = 0; ai < 2; ++ai)
#pragma unroll
            for (int m = 0; m < 4; ++m) { const int row = u.pm * 256 + ai * 128 + wr * 64 + m * 16 + fr;
                f32x4 g0 = acc[ai][0][m][0], g1 = acc[ai][0][m][1]; const f32x4 u0 = acc[ai][1][m][0], u1 = acc[ai][1][m][1];
                for (int j = 0; j < 4; ++j) { g0[j] = siluf_(g0[j]) * u0[j]; g1[j] = siluf_(g1[j]) * u1[j]; }
                *(u32x4*)(a + (size_t)row * FH + u.pn * 128 + wc * 32 + 8 * fq) = pack44(g0, g1); }
    }
};
}

template <int MODE> DI int rowmap(int n) {
    if (MODE == 1) return n < 5120 ? n : (n < 5136 ? 9216 + (n - 5120) : n - 16);
    if (MODE == 2) { if (n < 5632) return (n >> 7) * 256 + (n & 127); const int m = n - 5632; return (m >> 7) * 256 + 128 + (m & 127); }
    return n;
}
template <int MODE> DI void transpose_job(LAS unsigned char* lds, const float* src, int K, int N, bf16_t* dst) {
    LAS float* tl = (LAS float*)lds;
    const int tid = TID(), tn = (N + 63) >> 6, tk = K >> 6, ntile = tn * tk;
    for (int t = BID(); t < ntile; t += GDIM()) {
        const int k0 = (t / tn) * 64, n0 = (t % tn) * 64;
#pragma unroll
        for (int i = 0; i < 2; ++i) { const int kk = (tid >> 4) + 32 * i, nn = (tid & 15) * 4;
            f32x4 v = {0.f, 0.f, 0.f, 0.f}; if (n0 + nn < N) v = *(const f32x4*)(src + (size_t)(k0 + kk) * N + n0 + nn);
            tl[kk * 65 + nn] = v[0]; tl[kk * 65 + nn + 1] = v[1]; tl[kk * 65 + nn + 2] = v[2]; tl[kk * 65 + nn + 3] = v[3]; }
        lds_barrier();
        { const int n = tid >> 3, ko = (tid & 7) * 8;
          if (n0 + n < N) { float f[8];
#pragma unroll
              for (int j = 0; j < 8; ++j) f[j] = tl[(ko + j) * 65 + n];
              *(u32x4*)(dst + (size_t)rowmap<MODE>(n0 + n) * K + k0 + ko) = pack8(f); } }
        lds_barrier();
    }
}

DI void phase_weights(LAS unsigned char* lds, PP p, int l) {
    unsigned char* ws = p->ws;
    transpose_job<1>(lds, p->in[4] + (size_t)l * 2048 * 9232, 2048, 9232, (bf16_t*)(ws + O_WIN));
    transpose_job<0>(lds, p->in[13] + (size_t)l * 1024 * 1024, 1024, 1024, (bf16_t*)(ws + O_WGLU));
    transpose_job<0>(lds, p->in[19] + (size_t)l * 1024 * 2048, 1024, 2048, (bf16_t*)(ws + O_WUPS));
    transpose_job<0>(lds, p->in[20] + (size_t)l * 1024 * 2048, 1024, 2048, (bf16_t*)(ws + O_WUPG));
    transpose_job<0>(lds, p->in[21] + (size_t)l * 2048 * 2048, 2048, 2048, (bf16_t*)(ws + O_WOUT));
    transpose_job<2>(lds, p->in[24] + (size_t)l * 2048 * 11264, 2048, 11264, (bf16_t*)(ws + O_WF1));
    transpose_job<0>(lds, p->in[25] + (size_t)l * 5632 * 2048, 5632, 2048, (bf16_t*)(ws + O_WF2));
    { u32x4* z = (u32x4*)(ws + O_WIN + (size_t)9232 * 2048 * 2); const int nz = 240 * 2048 * 2 / 16;
      for (int i = BID() * NTHR + TID(); i < nz; i += GDIM() * NTHR) z[i] = (u32x4){0u, 0u, 0u, 0u}; }
}

DI void phase_mod(LAS unsigned char* lds, PP p) {
    LAS float* red = (LAS float*)lds;
    const int tid = TID(), col = tid & 63, kp = tid >> 6;
    const float* c = p->in[1];
    float* mod = (float*)(p->ws + O_MOD);
    for (int u = BID(); u < 384; u += GDIM()) {
        const int l = u / 192, c0 = (u % 192) * 64;
        const float* w = p->in[2] + (size_t)l * 2048 * 12288 + c0 + col;
        float s = 0.f;
        for (int k = kp * 256; k < kp * 256 + 256; ++k) { const float cv = c[k]; s += (cv / (1.f + expf(-cv))) * w[(size_t)k * 12288]; }
        red[kp * 64 + col] = s;
        __syncthreads();
        if (tid < 64) { float t = 0.f; for (int i = 0; i < 8; ++i) t += red[i * 64 + tid]; mod[l * 12288 + c0 + tid] = t + p->in[3][l * 12288 + c0 + tid]; }
        __syncthreads();
    }
}

DI void phase_s5pre(LAS unsigned char* lds, PP p, int l) {
    LAS float* apr = (LAS float*)lds;
    LAS float* api = apr + 33 * 64;
    LAS float* bbr = api + 33 * 64;
    LAS float* bbi = bbr + 1024;
    LAS float* ccr = bbi + 1024;
    LAS float* cci = ccr + 1024;
    LAS float* kt = cci + 1024;
    const int tid = TID();
    bf16_t* bt2 = (bf16_t*)(p->ws + O_BT2); bf16_t* m2 = (bf16_t*)(p->ws + O_M2); float* a32 = (float*)(p->ws + O_A32);
    for (int g = BID(); g < 64; g += GDIM()) {
        const float dt = expf(p->in[7][l * 64 + g]);
        for (int id = tid; id < 33 * 64; id += NTHR) { const int pp = id & 63, j = id >> 6;
            const float lr = p->in[5][(l * 64 + g) * 64 + pp], li = p->in[6][(l * 64 + g) * 64 + pp];
            const float mg = expf(lr * dt * (float)j), an = li * dt * (float)j; float sn, cs; sincosf(an, &sn, &cs); const float re = mg * cs, im = mg * sn;
            apr[j * 64 + pp] = re; api[j * 64 + pp] = im;
            if (j == 32) { a32[(g * 64 + pp) * 2] = re; a32[(g * 64 + pp) * 2 + 1] = im; } }
        for (int id = tid; id < 1024; id += NTHR) { const int pp = id >> 4, hi = id & 15;
            const float lr = p->in[5][(l * 64 + g) * 64 + pp], li = p->in[6][(l * 64 + g) * 64 + pp];
            const float mg = expf(lr * dt), an = li * dt; float sn, cs; sincosf(an, &sn, &cs); const float nr = mg * cs - 1.0f, ni = mg * sn, den = lr * lr + li * li;
            const float fr = (nr * lr + ni * li) / den, fi = (ni * lr - nr * li) / den;
            const size_t bo = ((size_t)(l * 64 + g) * 64 + pp) * 16 + hi; const float br = p->in[8][bo], bi = p->in[9][bo];
            bbr[id] = fr * br - fi * bi; bbi[id] = fr * bi + fi * br;
            const int ho = id >> 6, p2 = id & 63; const size_t co = ((size_t)(l * 64 + g) * 16 + ho) * 64 + p2;
            ccr[id] = p->in[10][co]; cci[id] = p->in[11][co]; }
        __syncthreads();
        for (int id = tid; id < 32 * 256; id += NTHR) { const int j = id >> 8, ho = (id >> 4) & 15, hi = id & 15; float s = 0.f;
            for (int pp = 0; pp < 64; ++pp) { const float ar = apr[j * 64 + pp], ai = api[j * 64 + pp], br = bbr[pp * 16 + hi], bi = bbi[pp * 16 + hi];
                const float wr_ = ar * br - ai * bi, wi_ = ar * bi + ai * br; s += ccr[ho * 64 + pp] * wr_ - cci[ho * 64 + pp] * wi_; }
            kt[id] = s; }
        __syncthreads();
        for (int id = tid; id < 512 * 80; id += NTHR) { const int n = id / 80, oc = id % 80, t = n >> 4, ho = n & 15; float f[8];
            if (oc < 64) { const int s = oc >> 1, hi0 = (oc & 1) * 8;
                for (int i = 0; i < 8; ++i) f[i] = (s <= t) ? kt[(t - s) * 256 + ho * 16 + hi0 + i] : 0.f;
            } else { for (int i = 0; i < 8; ++i) { const int cc = (oc - 64) * 8 + i, ri = cc >> 6, pp = cc & 63;
                const float ar = apr[(t + 1) * 64 + pp], ai = api[(t + 1) * 64 + pp], cr = ccr[ho * 64 + pp], ci = cci[ho * 64 + pp];
                f[i] = ri == 0 ? (cr * ar - ci * ai) : -(cr * ai + ci * ar); } }
            *(u32x4*)(bt2 + ((size_t)g * 512 + n) * 640 + oc * 8) = pack8(f); }
        for (int id = tid; id < 256 * 64; id += NTHR) { const int rr = id >> 6, oc = id & 63; float f[8];
            if (rr < 128) { const int ri = rr >> 6, pp = rr & 63, s = oc >> 1, hi0 = (oc & 1) * 8; const float ar = apr[(31 - s) * 64 + pp], ai = api[(31 - s) * 64 + pp];
                for (int i = 0; i < 8; ++i) { const float br = bbr[pp * 16 + hi0 + i], bi = bbi[pp * 16 + hi0 + i]; f[i] = ri == 0 ? (ar * br - ai * bi) : (ar * bi + ai * br); }
            } else { for (int i = 0; i < 8; ++i) f[i] = 0.f; }
            *(u32x4*)(m2 + ((size_t)g * 256 + rr) * 512 + oc * 8) = pack8(f); }
        __syncthreads();
    }
}

DI float wave_sum(float v) {
#pragma unroll
    for (int o = 32; o >= 1; o >>= 1) v += __shfl_xor(v, o);
    return v;
}
template <bool FIRST, bool SECOND>
DI void phase_ln(const float* src, const float* g, const float* b, float* dst1, const float* sh, const float* sc, bf16_t* dsth) {
    const int wid = TID() >> 6, lane = TID() & 63;
    for (int row = BID() * 8 + wid; row < L; row += GDIM() * 8) {
        float v[4][8];
#pragma unroll
        for (int i = 0; i < 4; ++i) { const f32x4 a = *(const f32x4*)(src + (size_t)row * DM + i * 512 + lane * 8), c = *(const f32x4*)(src + (size_t)row * DM + i * 512 + lane * 8 + 4);
            v[i][0] = a[0]; v[i][1] = a[1]; v[i][2] = a[2]; v[i][3] = a[3]; v[i][4] = c[0]; v[i][5] = c[1]; v[i][6] = c[2]; v[i][7] = c[3]; }
        if (FIRST) {
            float s = 0.f;
#pragma unroll
            for (int i = 0; i < 4; ++i) for (int k = 0; k < 8; ++k) s += v[i][k];
            const float mu = wave_sum(s) * (1.f / DM); float q = 0.f;
#pragma unroll
            for (int i = 0; i < 4; ++i) for (int k = 0; k < 8; ++k) { const float d = v[i][k] - mu; q += d * d; }
            const float rs = rsqrtf(wave_sum(q) * (1.f / DM) + 1e-5f);
#pragma unroll
            for (int i = 0; i < 4; ++i) { const int c0 = i * 512 + lane * 8;
                const f32x4 g0 = *(const f32x4*)(g + c0), g1 = *(const f32x4*)(g + c0 + 4), b0 = *(const f32x4*)(b + c0), b1 = *(const f32x4*)(b + c0 + 4);
                for (int k = 0; k < 4; ++k) { v[i][k] = (v[i][k] - mu) * rs * g0[k] + b0[k]; v[i][4 + k] = (v[i][4 + k] - mu) * rs * g1[k] + b1[k]; }
                *(f32x4*)(dst1 + (size_t)row * DM + c0) = (f32x4){v[i][0], v[i][1], v[i][2], v[i][3]};
                *(f32x4*)(dst1 + (size_t)row * DM + c0 + 4) = (f32x4){v[i][4], v[i][5], v[i][6], v[i][7]}; }
        }
        if (SECOND) {
            float s = 0.f;
#pragma unroll
            for (int i = 0; i < 4; ++i) for (int k = 0; k < 8; ++k) s += v[i][k];
            const float mu = wave_sum(s) * (1.f / DM); float q = 0.f;
#pragma unroll
            for (int i = 0; i < 4; ++i) for (int k = 0; k < 8; ++k) { const float d = v[i][k] - mu; q += d * d; }
            const float rs = rsqrtf(wave_sum(q) * (1.f / DM) + 1e-5f);
#pragma unroll
            for (int i = 0; i < 4; ++i) { const int c0 = i * 512 + lane * 8; float f[8];
                const f32x4 s0 = *(const f32x4*)(sc + c0), s1 = *(const f32x4*)(sc + c0 + 4), h0 = *(const f32x4*)(sh + c0), h1 = *(const f32x4*)(sh + c0 + 4);
                for (int k = 0; k < 4; ++k) { f[k] = (v[i][k] - mu) * rs * (1.f + s0[k]) + h0[k]; f[4 + k] = (v[i][4 + k] - mu) * rs * (1.f + s1[k]) + h1[k]; }
                *(u32x4*)(dsth + (size_t)row * DM + c0) = pack8(f); }
        }
    }
}

DI void phase_carry(PP p, int bid) {
    const int id = bid * NTHR + TID();
    if (id >= 4096) return;
    const int g = id >> 6, pp = id & 63;
    const float* a32 = (const float*)(p->ws + O_A32); const float* xe = (const float*)(p->ws + O_XEND) + (size_t)g * 512 * 128 + pp;
    bf16_t* up = (bf16_t*)(p->ws + O_E) + (size_t)g * 512 * 640 + 512 + pp;
    const float ar = a32[id * 2], ai = a32[id * 2 + 1];
    float xr = 0.f, xi = 0.f;
#pragma unroll 32
    for (int c = 0; c < 512; ++c) {
        up[(size_t)c * 640] = f2bf(xr); up[(size_t)c * 640 + 64] = f2bf(xi);
        const float er = xe[(size_t)c * 128], ei = xe[(size_t)c * 128 + 64];
        const float nr = ar * xr - ai * xi + er, ni = ar * xi + ai * xr + ei; xr = nr; xi = ni;
    }
}

constexpr int QN_O = 0, KN_O = 17408, XTK_O = 34816, XTV_O = 53248, KT2_O = 71680, TIMG_O = 90112, MM_O = 99328, AT_O = 116736, SC_O = 134144;
DI void gdn_intra(LAS unsigned char* lds, PP p, int l, int item) {
    { unsigned lb = (unsigned)(size_t)lds; asm volatile("" : "+v"(lb)); lds = (LAS unsigned char*)lb; }
    const int tid = TID(), w = tid >> 6, lane = tid & 63, r = lane & 31, h = lane >> 5;
    const int hd = item >> 8, n = item & 255, tok0 = n * 64;
    LAS bf16_t* Qn = (LAS bf16_t*)(lds + QN_O); LAS bf16_t* Kn = (LAS bf16_t*)(lds + KN_O);
    LAS bf16_t* XTk = (LAS bf16_t*)(lds + XTK_O); LAS bf16_t* XTv = (LAS bf16_t*)(lds + XTV_O); LAS bf16_t* KT2 = (LAS bf16_t*)(lds + KT2_O);
    LAS bf16_t* Timg = (LAS bf16_t*)(lds + TIMG_O); LAS float* Mm = (LAS float*)(lds + MM_O); LAS float* At = (LAS float*)(lds + AT_O);
    LAS float* scb = (LAS float*)(lds + SC_O); LAS float* scg = scb + 64; LAS float* sce = scb + 128; LAS float* scl = scb + 192;
    const float* logit = (const float*)(p->ws + O_LOG);
    const bf16_t* qkv = (const bf16_t*)(p->ws + O_QKV);
    unsigned char* fb = p->ws + O_A + (size_t)item * FRAG_ITEM;
    unsigned char* ub = p->ws + O_UFR + (size_t)item * UFR_ITEM;
    if (tid < 64) {
        const int tok = tok0 + tid;
        const float bl = logit[(size_t)tok * 16 + hd], al = logit[(size_t)tok * 16 + 8 + hd];
        const float beta = 1.f / (1.f + __expf(-bl));
        const float xx = al + p->in[17][l * 8 + hd];
        const float ex = __expf(fminf(xx, 20.f));
        const float sp = xx > 20.f ? xx : (ex < 0.05f ? ex * (1.f - ex * (0.5f - ex * (0.33333333f - ex * 0.25f))) : __logf(1.f + ex));
        float gc = -__expf(p->in[16][l * 8 + hd]) * sp;
#pragma unroll
        for (int off = 1; off < 64; off <<= 1) { const float t = __shfl_up(gc, off); if (tid >= off) gc += t; }
        const float gl = __shfl(gc, 63);
        scb[tid] = beta; scg[tid] = gc; sce[tid] = __expf(gc); scl[tid] = __expf(gl - gc);
        if (tid == 0) ((float*)(p->ws + O_GL))[hd * 256 + n] = __expf(gl);
    }
    lds_barrier();
    const float* cw = p->in[15] + (size_t)l * 4 * 3072;
#pragma unroll 1
    for (int mat = 0; mat < 3; ++mat) {
#pragma unroll 1
        for (int it = 0; it < 2; ++it) {
            const int id = tid + NTHR * it, j = id >> 4, o = id & 15, col = mat * 1024 + hd * 128 + o * 8;
            float a[8];
#pragma unroll
            for (int i = 0; i < 8; ++i) a[i] = 0.f;
#pragma unroll
            for (int kk = 0; kk < 4; ++kk) { const int t = tok0 + j - 3 + kk;
                if (t >= 0) { float x[8]; unpack8(*(const u32x4*)(qkv + (size_t)t * 3072 + col), x);
                    const f32x4 w0 = *(const f32x4*)(cw + kk * 3072 + col), w1 = *(const f32x4*)(cw + kk * 3072 + col + 4);
                    for (int i = 0; i < 4; ++i) { a[i] += w0[i] * x[i]; a[4 + i] += w1[i] * x[4 + i]; } } }
#pragma unroll
            for (int i = 0; i < 8; ++i) a[i] = a[i] / (1.f + __expf(-a[i]));
            if (mat < 2) {
                float ss = 0.f;
#pragma unroll
                for (int i = 0; i < 8; ++i) ss += a[i] * a[i];
                ss += __shfl_xor(ss, 1); ss += __shfl_xor(ss, 2); ss += __shfl_xor(ss, 4); ss += __shfl_xor(ss, 8);
                const float sc = rsqrtf(ss + 1e-6f) * (mat == 0 ? 0.08838834764831845f : 1.f);
#pragma unroll
                for (int i = 0; i < 8; ++i) a[i] *= sc;
            }
            if (mat == 0) {
                *(LAS u32x4*)(Qn + j * 136 + o * 8) = pack8(a);
                const float eg = sce[j]; const int ct = j >> 5, s = o >> 1, part = o & 1;
                unsigned char* q0 = fb + 16384 + ((size_t)((ct * 8 + s) * 64 + (j & 31))) * 16 + 8 * part;
                u32x2 lo, hi2; lo.x = pk2(a[0] * eg, a[1] * eg); lo.y = pk2(a[2] * eg, a[3] * eg); hi2.x = pk2(a[4] * eg, a[5] * eg); hi2.y = pk2(a[6] * eg, a[7] * eg);
                *(u32x2*)q0 = lo; *(u32x2*)(q0 + 32 * 16) = hi2;
            } else if (mat == 1) {
                *(LAS u32x4*)(Kn + j * 136 + o * 8) = pack8(a);
                const float f1 = scb[j] * sce[j], f2 = scl[j];
#pragma unroll
                for (int i = 0; i < 8; ++i) { XTk[(o * 8 + i) * 72 + j] = f2bf(a[i] * f1); KT2[(o * 8 + i) * 72 + j] = f2bf(a[i] * f2); }
            } else {
                const float f1 = scb[j];
#pragma unroll
                for (int i = 0; i < 8; ++i) XTv[(o * 8 + i) * 72 + j] = f2bf(a[i] * f1);
            }
        }
    }
    lds_barrier();
    {
        const int isq = w >> 2, it = (w & 3) >> 1, jt = w & 1;
        LAS bf16_t* Ai = isq ? Qn : Kn;
        f32x16 acc; for (int i = 0; i < 16; ++i) acc[i] = 0.f;
#pragma unroll
        for (int s = 0; s < 8; ++s) { const bf16x8 a = *(const LAS bf16x8*)(Ai + (32 * it + r) * 136 + 16 * s + 8 * h), b = *(const LAS bf16x8*)(Kn + (32 * jt + r) * 136 + 16 * s + 8 * h);
            acc = MFMA32(a, b, acc); }
        const int col = 32 * jt + r; const float gcc = scg[col];
#pragma unroll
        for (int i = 0; i < 16; ++i) { const int row = 32 * it + crow(i, h);
            if (isq) At[row * 68 + col] = (row >= col) ? acc[i] * __expf(scg[row] - gcc) : 0.f;
            else Mm[row * 68 + col] = (row > col) ? scb[row] * acc[i] * __expf(scg[row] - gcc) : 0.f; }
    }
    lds_barrier();
    if (w == 0) {
        float t[64]; const float lanef = (float)lane;
#pragma unroll
        for (int i = 0; i < 64; ++i) {
            float a0 = fmaxf(0.f, 1.f - fabsf(lanef - (float)i)), a1 = 0.f;
#pragma unroll
            for (int j4 = 0; j4 < (i + 3) / 4; ++j4) { const f32x4 mv = *(const LAS f32x4*)(Mm + i * 68 + j4 * 4);
#pragma unroll
                for (int jj = 0; jj < 4; ++jj) { const int j = j4 * 4 + jj; if (j < i) { if (jj & 1) a1 -= mv[jj] * t[j]; else a0 -= mv[jj] * t[j]; } } }
            t[i] = a0 + a1;
            if ((i & 3) == 3) asm volatile("" ::: "memory");
        }
#pragma unroll
        for (int i = 0; i < 64; ++i) Timg[i * 72 + lane] = f2bf(t[i]);
    } else {
        for (int id = tid - 64; id < 1536; id += 448) {
            const int ln = id & 63, rr = ln & 31, hh = ln >> 5;
            if (id < 1024) { const int f = id >> 6, dt = f >> 2, s = f & 3; const int d = 32 * dt + rr;
                const u32x2 lo = *(const LAS u32x2*)(KT2 + d * 72 + 16 * s + 4 * hh), hi2 = *(const LAS u32x2*)(KT2 + d * 72 + 16 * s + 8 + 4 * hh);
                *(u32x4*)(fb + 40960 + (size_t)(f * 64 + ln) * 16) = (u32x4){lo.x, lo.y, hi2.x, hi2.y};
            } else { const int f = (id - 1024) >> 6, ct = f >> 2, s = f & 3; const int row = 32 * ct + rr;
                const f32x4 lo = *(const LAS f32x4*)(At + row * 68 + 16 * s + 4 * hh), hi2 = *(const LAS f32x4*)(At + row * 68 + 16 * s + 8 + 4 * hh);
                *(u32x4*)(fb + 32768 + (size_t)(f * 64 + ln) * 16) = pack44(lo, hi2); }
        }
    }
    lds_barrier();
    {
        const int ct = w >> 2, et = w & 3;
        f32x16 acc; for (int i = 0; i < 16; ++i) acc[i] = 0.f;
#pragma unroll
        for (int s = 0; s < 4; ++s) { const bf16x8 a = *(const LAS bf16x8*)(Timg + (32 * ct + r) * 72 + 16 * s + 8 * h), b = *(const LAS bf16x8*)(XTv + (32 * et + r) * 72 + 16 * s + 8 * h);
            acc = MFMA32(a, b, acc); }
        float* ud = (float*)(ub + (size_t)(ct * 4 + et) * 4096 + lane * 64);
#pragma unroll
        for (int q = 0; q < 4; ++q) *(f32x4*)(ud + 4 * q) = (f32x4){acc[4 * q], acc[4 * q + 1], acc[4 * q + 2], acc[4 * q + 3]};
        const int dt = w >> 1, c2 = w & 1;
        f32x16 ac2; for (int i = 0; i < 16; ++i) ac2[i] = 0.f;
#pragma unroll
        for (int s = 0; s < 4; ++s) { const bf16x8 a = *(const LAS bf16x8*)(XTk + (32 * dt + r) * 72 + 16 * s + 8 * h), b = *(const LAS bf16x8*)(Timg + (32 * c2 + r) * 72 + 16 * s + 8 * h);
            ac2 = MFMA32(a, b, ac2); }
#pragma unroll
        for (int sp = 0; sp < 2; ++sp) { u32x4 wv; wv.x = pk2(ac2[8 * sp], ac2[8 * sp + 1]); wv.y = pk2(ac2[8 * sp + 2], ac2[8 * sp + 3]); wv.z = pk2(ac2[8 * sp + 4], ac2[8 * sp + 5]); wv.w = pk2(ac2[8 * sp + 6], ac2[8 * sp + 7]);
            *(u32x4*)(fb + (size_t)((c2 * 8 + 2 * dt + sp) * 64 + lane) * 16) = wv; }
    }
    lds_barrier();
}

DI void gdn_scan(LAS unsigned char* lds, PP p, int wg) {
    const int tid = TID(), w = tid >> 6, lane = tid & 63, r = lane & 31, h = lane >> 5;
    const int hd = wg >> 1, cb = wg & 1, rt = w >> 1, et = w & 1;
    LAS u32x4* Simg = (LAS u32x4*)lds;
    LAS u32x4* Vimg = (LAS u32x4*)(lds + 16384);
    f32x16 S; for (int i = 0; i < 16; ++i) S[i] = 0.f;
    Simg[((2 * rt) * 2 + et) * 64 + lane] = (u32x4){0u, 0u, 0u, 0u}; Simg[((2 * rt + 1) * 2 + et) * 64 + lane] = (u32x4){0u, 0u, 0u, 0u};
    lds_barrier();
    const unsigned char* fb = p->ws + O_A + (size_t)(hd * 256) * FRAG_ITEM;
    const unsigned char* ub = p->ws + O_UFR + (size_t)(hd * 256) * UFR_ITEM;
    const float* GL = (const float*)(p->ws + O_GL) + hd * 256;
    bf16_t* obf = (bf16_t*)(p->ws + O_OBF);
    const size_t a1off = (rt < 2 ? 0 : 16384) + (size_t)((rt & 1) * 8) * 1024 + lane * 16;
    const size_t ktoff = 40960 + (size_t)(rt * 4) * 1024 + lane * 16;
    const unsigned char* xbase = rt >= 2 ? fb + 32768 + (size_t)((rt & 1) * 4) * 1024 + lane * 16 : ub + (size_t)((rt & 1) * 4 + 2 * cb + et) * 4096 + lane * 64;
    const size_t xitem = rt >= 2 ? FRAG_ITEM : UFR_ITEM, xstep = rt >= 2 ? 1024 : 16;
#define SCAN_LOAD_A1(A1_, n_) do { const unsigned char* f_ = fb + (size_t)(n_) * FRAG_ITEM + a1off; \
        _Pragma("unroll") for (int s = 0; s < 8; ++s) A1_[s] = *(const bf16x8*)(f_ + s * 1024); } while (0)
#define SCAN_LOAD_X(KT_, X_, n_) do { const unsigned char* f_ = fb + (size_t)(n_) * FRAG_ITEM + ktoff; const unsigned char* x_ = xbase + (size_t)(n_) * xitem; \
        _Pragma("unroll") for (int s = 0; s < 4; ++s) { KT_[s] = *(const bf16x8*)(f_ + s * 1024); X_[s] = *(const u32x4*)(x_ + s * xstep); } } while (0)
#define SCAN_STEP(n_, A1_, KT_, X_) do { \
        const float gl = GL[n_]; const int n2_ = (n_) + 2 < 256 ? (n_) + 2 : 255; \
        f32x16 acc; for (int i = 0; i < 16; ++i) acc[i] = 0.f; \
        _Pragma("unroll") for (int s = 0; s < 8; ++s) { const bf16x8 b = __builtin_bit_cast(bf16x8, Simg[(s * 2 + et) * 64 + lane]); acc = MFMA32(A1_[s], b, acc); } \
        SCAN_LOAD_A1(A1_, n2_); \
        if (rt < 2) { \
            _Pragma("unroll") for (int sp = 0; sp < 2; ++sp) { float v[8]; \
                _Pragma("unroll") for (int j = 0; j < 8; ++j) v[j] = __builtin_bit_cast(f32x4, X_[(8 * sp + j) >> 2])[(8 * sp + j) & 3] - acc[8 * sp + j]; \
                Vimg[((2 * rt + sp) * 2 + et) * 64 + lane] = pack8(v); } } \
        lds_barrier(); \
        _Pragma("unroll") for (int i = 0; i < 16; ++i) S[i] *= gl; \
        _Pragma("unroll") for (int s = 0; s < 4; ++s) { const bf16x8 b = __builtin_bit_cast(bf16x8, Vimg[(s * 2 + et) * 64 + lane]); S = MFMA32(KT_[s], b, S); \
            if (rt >= 2) acc = MFMA32(__builtin_bit_cast(bf16x8, X_[s]), b, acc); } \
        SCAN_LOAD_X(KT_, X_, n2_); \
        if (rt >= 2) { const int col = hd * 128 + 64 * cb + 32 * et + r; \
            _Pragma("unroll") for (int i = 0; i < 16; ++i) { const int tok = 64 * (n_) + 32 * (rt - 2) + crow(i, h); obf[(size_t)tok * 1024 + col] = f2bf(acc[i]); } } \
        _Pragma("unroll") for (int sp = 0; sp < 2; ++sp) { float v[8]; \
            _Pragma("unroll") for (int j = 0; j < 8; ++j) v[j] = S[8 * sp + j]; \
            Simg[((2 * rt + sp) * 2 + et) * 64 + lane] = pack8(v); } \
        lds_barrier(); } while (0)
    bf16x8 A1a[8], A1b[8], KTa[4], KTb[4]; u32x4 Xa[4], Xb[4];
    SCAN_LOAD_A1(A1a, 0); SCAN_LOAD_X(KTa, Xa, 0); SCAN_LOAD_A1(A1b, 1); SCAN_LOAD_X(KTb, Xb, 1);
    for (int n = 0; n < 256; n += 2) {
        SCAN_STEP(n, A1a, KTa, Xa);
        SCAN_STEP(n + 1, A1b, KTb, Xb);
    }
#undef SCAN_LOAD_A1
#undef SCAN_LOAD_X
#undef SCAN_STEP
}

DI void phase_normgate(PP p, int l, int nblk, int bid) {
    bf16_t* obf = (bf16_t*)(p->ws + O_OBF); const bf16_t* z = (const bf16_t*)(p->ws + O_Z);
    const int o8 = TID() & 15;
    const f32x4 w0 = *(const f32x4*)(p->in[18] + l * 128 + o8 * 8), w1 = *(const f32x4*)(p->in[18] + l * 128 + o8 * 8 + 4);
    for (int grp = bid * 32 + (TID() >> 4); grp < L * 8; grp += nblk * 32) {
        const size_t base = (size_t)(grp >> 3) * 1024 + (grp & 7) * 128 + o8 * 8;
        float o[8], zz[8]; unpack8(*(const u32x4*)(obf + base), o); unpack8(*(const u32x4*)(z + base), zz);
        float ss = 0.f;
#pragma unroll
        for (int i = 0; i < 8; ++i) ss += o[i] * o[i];
        ss += __shfl_xor(ss, 1); ss += __shfl_xor(ss, 2); ss += __shfl_xor(ss, 4); ss += __shfl_xor(ss, 8);
        const float sc = rsqrtf(ss * (1.f / 128.f) + 1e-6f);
#pragma unroll
        for (int i = 0; i < 4; ++i) { o[i] = o[i] * sc * w0[i] * siluf_(zz[i]); o[4 + i] = o[4 + i] * sc * w1[i] * siluf_(zz[4 + i]); }
        *(u32x4*)(obf + base) = pack8(o);
    }
}

__global__ void __launch_bounds__(512, 2) hybrid_fwd(Params p_arg) {
    extern __shared__ __attribute__((aligned(16))) unsigned char shm[];
    LAS unsigned char* lds = (LAS unsigned char*)shm;
    cg::grid_group grid = cg::this_grid();
    using namespace pg8;

    for (int st = 0; st < 26; ++st) {
        const int l = st < 2 ? 0 : (st - 2) / 12;
        const int ph = st < 2 ? st : 2 + (st - 2) % 12;
        PP p = (PP)__builtin_amdgcn_kernarg_segment_ptr();
        asm volatile("" : "+s"(p));
        const int G = GDIM(), bid = BID();
        unsigned char* ws = p->ws;
        float* mod = (float*)(ws + O_MOD);
        bf16_t* hbuf = (bf16_t*)(ws + O_D);
        float* vbuf = (float*)(ws + O_B);
        const float* ml = mod + l * 12288;
        switch (ph) {
        case 0:
            phase_mod(lds, p); phase_weights(lds, p, 0); phase_s5pre(lds, p, 0);
            break;
        case 1:
            phase_ln<false, true>(p->in[0], nullptr, nullptr, nullptr, mod + 0, mod + 2048, hbuf);
            break;
        case 2: {
            Gemm g{hbuf, (const bf16_t*)(ws + O_WIN), DM, DM, DM}; StaticOrder S; S.init(L, NPROJ, G, bid);
            EpiProj E{(bf16_t*)(ws + O_E), (bf16_t*)(ws + O_QKV), (bf16_t*)(ws + O_Z), (bf16_t*)(ws + O_SGS), (bf16_t*)(ws + O_SGG), (float*)(ws + O_LOG)};
            gemm_phase(lds, g, S, E); } break;
        case 3: {
            Gemm g{(const bf16_t*)(ws + O_E), (const bf16_t*)(ws + O_M2), 640, 512, 512}; OrderS5X S{G, bid}; EpiXend E{(float*)(ws + O_XEND)};
            gemm_phase(lds, g, S, E); } break;
        case 4:
            if (bid < 8) phase_carry(p, bid);
            else { for (int item = bid - 8; item < 2048; item += G - 8) gdn_intra(lds, p, l, item); }
            break;
        case 5:
            if (bid < 16) gdn_scan(lds, p, bid);
            else { Gemm g{(const bf16_t*)(ws + O_E), (const bf16_t*)(ws + O_BT2), 640, 640, 640}; OrderS5Y S{G - 16, bid - 16};
                   EpiS5Y E{(const bf16_t*)(ws + O_E), p->in[12] + l * 1024, (bf16_t*)(ws + O_ZS)}; gemm_phase(lds, g, S, E); }
            break;
        case 6: {
            phase_normgate(p, l, G, bid);
            Gemm g{(const bf16_t*)(ws + O_ZS), (const bf16_t*)(ws + O_WGLU), 1024, 1024, 1024}; StaticOrder S; S.init(L, 1024, G, bid);
            EpiGlu E{(const bf16_t*)(ws + O_ZS), p->in[14] + l * 1024, (bf16_t*)(ws + O_Y2)}; gemm_phase(lds, g, S, E); } break;
        case 7: {
            Gemm g{(const bf16_t*)(ws + O_Y2), (const bf16_t*)(ws + O_WUPS), 1024, 1024, 1024}; StaticOrder S; S.init(L, 2048, G, bid);
            EpiUp<0> E{(const bf16_t*)(ws + O_SGS), nullptr, (bf16_t*)(ws + O_T1)}; gemm_phase(lds, g, S, E); } break;
        case 8: {
            Gemm g{(const bf16_t*)(ws + O_OBF), (const bf16_t*)(ws + O_WUPG), 1024, 1024, 1024}; StaticOrder S; S.init(L, 2048, G, bid);
            EpiUp<1> E{(const bf16_t*)(ws + O_SGG), (const bf16_t*)(ws + O_T1), (bf16_t*)(ws + O_MRG)}; gemm_phase(lds, g, S, E); } break;
        case 9: {
            const float* xin = l == 0 ? p->in[0] : p->out;
            Gemm g{(const bf16_t*)(ws + O_MRG), (const bf16_t*)(ws + O_WOUT), DM, DM, DM}; StaticOrder S; S.init(L, DM, G, bid);
            EpiResid E{xin, ml + 4096, vbuf}; gemm_phase(lds, g, S, E); } break;
        case 10:
            phase_ln<true, true>(vbuf, p->in[22] + l * DM, p->in[23] + l * DM, vbuf, ml + 6144, ml + 8192, hbuf);
            break;
        case 11: {
            Gemm g{hbuf, (const bf16_t*)(ws + O_WF1), DM, DM, DM}; StaticOrder S; S.init(L, 2 * FH, G, bid);
            EpiSwiglu E{(bf16_t*)(ws + O_A)}; gemm_phase(lds, g, S, E); } break;
        case 12: {
            Gemm g{(const bf16_t*)(ws + O_A), (const bf16_t*)(ws + O_WF2), FH, FH, FH}; StaticOrder S; S.init(L, DM, G, bid);
            EpiResid E{vbuf, ml + 10240, vbuf}; gemm_phase(lds, g, S, E); } break;
        default:
            if (l == 0) {
                phase_ln<true, true>(vbuf, p->in[26], p->in[27], p->out, mod + 12288, mod + 12288 + 2048, hbuf);
                __syncthreads();
                phase_weights(lds, p, 1);
                phase_s5pre(lds, p, 1);
            } else {
                phase_ln<true, false>(vbuf, p->in[26] + DM, p->in[27] + DM, p->out, nullptr, nullptr, nullptr);
            }
            break;
        }
        if (st == 0) grid.sync();
        else if (st != 25) gbar((unsigned*)(ws + O_BAR), (unsigned)(st * G));
    }
}

extern "C" void kernel_launch(void* const* d_in, const int* in_sizes, int n_in, void* d_out, int out_size, void* d_ws, size_t ws_size, hipStream_t stream) {
    static int grid_blocks = 0;
    if (grid_blocks == 0) {
        if (n_in != 28 || ws_size < WS_END) { fprintf(stderr, "kernel_launch: need 28 inputs and %zu bytes of workspace; got %d, %zu\n", (size_t)WS_END, n_in, ws_size); grid_blocks = -1; return; }
        int dev = 0, cus = 0, per_cu = 0;
        hipGetDevice(&dev);
        hipDeviceGetAttribute(&cus, hipDeviceAttributeMultiprocessorCount, dev);
        if (hipFuncSetAttribute((const void*)hybrid_fwd, hipFuncAttributeMaxDynamicSharedMemorySize, LDS_BYTES) != hipSuccess) { fprintf(stderr, "kernel_launch: hipFuncSetAttribute failed\n"); grid_blocks = -1; return; }
        hipOccupancyMaxActiveBlocksPerMultiprocessor(&per_cu, (const void*)hybrid_fwd, NTHR, LDS_BYTES);
        if (per_cu < 1) { fprintf(stderr, "kernel_launch: occupancy query says %d blocks per CU\n", per_cu); per_cu = 1; }
        (void)hipGetLastError();
        grid_blocks = cus;
    }
    if (grid_blocks < 0) return;
    Params p{};
    for (int i = 0; i < 28; ++i) p.in[i] = (const float*)d_in[i];
    p.out = (float*)d_out; p.ws = (unsigned char*)d_ws;
    if (hipMemsetAsync((char*)d_ws + O_BAR, 0, 256, stream) != hipSuccess) { fprintf(stderr, "kernel_launch: hipMemsetAsync failed\n"); return; }
    void* args[] = {&p};
    hipError_t e = hipLaunchCooperativeKernel((const void*)hybrid_fwd, dim3(grid_blocks), dim3(NTHR), args, LDS_BYTES, stream);
    if (e != hipSuccess) fprintf(stderr, "cooperative launch failed: %s (grid %d)\n", hipGetErrorString(e), grid_blocks);
}
```

```cpp
#include <hip/hip_runtime.h>
#include <hip/hip_cooperative_groups.h>
#include <cstdio>
namespace cg = cooperative_groups;

#define LAS __attribute__((address_space(3)))
#define DI __device__ __forceinline__
typedef unsigned short bf16_t;
typedef short bf16x8 __attribute__((ext_vector_type(8)));
typedef float f32x2 __attribute__((ext_vector_type(2)));
typedef float f32x4 __attribute__((ext_vector_type(4)));
typedef float f32x16 __attribute__((ext_vector_type(16)));
typedef unsigned u32x4 __attribute__((ext_vector_type(4)));
typedef unsigned u32x2 __attribute__((ext_vector_type(2)));
typedef __bf16 bf2_t __attribute__((ext_vector_type(2)));

constexpr int L = 16384, DM = 2048, NPROJ = 9472, FH = 5632, NTHR = 512;
constexpr float ALPHA = 1.41421356237f;
constexpr int LDS_BYTES = 143360;

constexpr size_t SZ_WIN = (size_t)NPROJ * DM * 2, SZ_WGLU = 1024ull * 1024 * 2, SZ_WUP = 2048ull * 1024 * 2, SZ_WOUT = 2048ull * 2048 * 2,
                 SZ_WF1 = 11264ull * 2048 * 2, SZ_WF2 = 2048ull * 5632 * 2;
constexpr size_t O_WIN = 0, O_WGLU = O_WIN + SZ_WIN, O_WUPS = O_WGLU + SZ_WGLU, O_WUPG = O_WUPS + SZ_WUP, O_WOUT = O_WUPG + SZ_WUP,
                 O_WF1 = O_WOUT + SZ_WOUT, O_WF2 = O_WF1 + SZ_WF1;
constexpr size_t SZ_BT2 = 64ull * 512 * 640 * 2, SZ_M2 = 64ull * 256 * 512 * 2;
constexpr size_t O_BT2 = O_WF2 + SZ_WF2, O_M2 = O_BT2 + SZ_BT2;
constexpr size_t SZ_A = (size_t)L * FH * 2;
constexpr size_t O_A = O_M2 + SZ_M2;
constexpr size_t FRAG_ITEM = 57344, UFR_ITEM = 32768;
constexpr size_t O_UFR = O_A + 2048 * FRAG_ITEM;
constexpr size_t O_Y2 = O_A, O_T1 = O_A + (size_t)L * 1024 * 2, O_MRG = O_T1 + (size_t)L * 2048 * 2;
constexpr size_t SZ_B = (size_t)L * DM * 4;
constexpr size_t O_B = O_A + SZ_A, O_QKV = O_B, O_Z = O_B + (size_t)L * 3072 * 2;
constexpr size_t O_C = O_B + SZ_B, O_SGS = O_C, O_SGG = O_C + (size_t)L * 2048 * 2;
constexpr size_t O_D = O_C + 2 * (size_t)L * 2048 * 2;
constexpr size_t O_ZS = O_D, O_OBF = O_D + (size_t)L * 1024 * 2;
constexpr size_t O_E = O_D + (size_t)L * 2048 * 2;
constexpr size_t O_LOG = O_E + 64ull * 512 * 640 * 2;
constexpr size_t O_XEND = O_LOG + (size_t)L * 16 * 4;
constexpr size_t O_MOD = O_XEND + 64ull * 512 * 128 * 4;
constexpr size_t O_A32 = O_MOD + 2 * 12288 * 4;
constexpr size_t O_GL = O_A32 + 64 * 64 * 2 * 4;
constexpr size_t O_BAR = O_GL + 8 * 256 * 4;
constexpr size_t WS_END = O_BAR + 8192;

struct Params {
    const float* in[28];
    float* out;
    unsigned char* ws;
};

extern "C" __device__ size_t __ockl_get_num_groups(unsigned);
typedef const __attribute__((address_space(4))) Params* PP;
DI int TID() { int t = __builtin_amdgcn_workitem_id_x(); asm volatile("" : "+v"(t)); return t; }
DI int GDIM() { return (int)__ockl_get_num_groups(0); }
DI int BID() { int t = __builtin_amdgcn_workgroup_id_x(); asm volatile("" : "+s"(t)); return t; }
DI unsigned pk2(float lo, float hi) { f32x2 v = {lo, hi}; bf2_t b = __builtin_convertvector(v, bf2_t); return __builtin_bit_cast(unsigned, b); }
DI bf16_t f2bf(float f) { return (bf16_t)(pk2(f, 0.f) & 0xffffu); }
DI float bflo(unsigned w) { return __uint_as_float(w << 16); }
DI float bfhi(unsigned w) { return __uint_as_float(w & 0xffff0000u); }
DI void unpack8(u32x4 w, float* f) { f[0] = bflo(w.x); f[1] = bfhi(w.x); f[2] = bflo(w.y); f[3] = bfhi(w.y); f[4] = bflo(w.z); f[5] = bfhi(w.z); f[6] = bflo(w.w); f[7] = bfhi(w.w); }
DI u32x4 pack8(const float* f) { u32x4 w; w.x = pk2(f[0], f[1]); w.y = pk2(f[2], f[3]); w.z = pk2(f[4], f[5]); w.w = pk2(f[6], f[7]); return w; }
DI u32x4 pack44(f32x4 a, f32x4 b) { u32x4 w; w.x = pk2(a[0], a[1]); w.y = pk2(a[2], a[3]); w.z = pk2(b[0], b[1]); w.w = pk2(b[2], b[3]); return w; }
DI float sigmoidf_(float x) { return 1.f / (1.f + __expf(-x)); }
DI float siluf_(float x) { return x / (1.f + __expf(-x)); }
DI float gelu_tanh(float y) { float t = 0.7978845608f * (y + 0.044715f * y * y * y); float e = __expf(2.f * t); return 0.5f * y * (2.f - 2.f / (e + 1.f)); }
DI void lds_barrier() { asm volatile("s_waitcnt lgkmcnt(0)" ::: "memory"); __builtin_amdgcn_s_barrier(); asm volatile("" ::: "memory"); }
DI unsigned xcc_id() { return (unsigned)__builtin_amdgcn_s_getreg((3 << 11) | 20) & 7u; }
DI void gbar(unsigned* bar, unsigned k, unsigned nx, unsigned nxcc, unsigned xcc) {
    asm volatile("s_waitcnt vmcnt(0) lgkmcnt(0)" ::: "memory");
    __builtin_amdgcn_s_barrier();
    if (__builtin_amdgcn_workitem_id_x() == 0) {
        const unsigned old = __hip_atomic_fetch_add(bar + 64 * xcc, 1u, __ATOMIC_RELAXED, __HIP_MEMORY_SCOPE_AGENT);
        if (old + 1u == k * nx) {
            __builtin_amdgcn_fence(__ATOMIC_RELEASE, "agent");
            asm volatile("s_waitcnt vmcnt(0) lgkmcnt(0)" ::: "memory");
            __hip_atomic_fetch_add(bar + 1024, 1u, __ATOMIC_RELAXED, __HIP_MEMORY_SCOPE_AGENT);
        }
        while (__hip_atomic_load(bar + 1024, __ATOMIC_RELAXED, __HIP_MEMORY_SCOPE_AGENT) < k * nxcc) __builtin_amdgcn_s_sleep(1);
    }
    asm volatile("" ::: "memory");
    __builtin_amdgcn_s_barrier();
    __builtin_amdgcn_fence(__ATOMIC_ACQUIRE, "agent");
    asm volatile("s_waitcnt vmcnt(0)" ::: "memory");
}
DI int crow(int reg, int h) { return (reg & 3) + 8 * (reg >> 2) + 4 * h; }
#define MFMA32(a, b, c) __builtin_amdgcn_mfma_f32_32x32x16_bf16((a), (b), (c), 0, 0, 0)

namespace pg8 {
constexpr int BM = 256, BK = 64, HALF = 128, HTB = HALF * BK * 2, STAGE_BYTES = 8 * HTB, NXCD = 8, WGM = 8;
DI int lds_byte(int r, int c) { const int st = (r >> 4) * 2 + (c >> 5), rr = r & 15, cc = c & 31, ob = rr * 64 + cc * 2; return st * 1024 + (ob ^ (((ob >> 9) & 1) << 5)); }
DI void stage_rc(int b, int& R, int& C) { const int st = b / 1024, sb = b % 1024, swz = sb ^ (((sb >> 9) & 1) << 5); R = (st >> 1) * 16 + swz / 64; C = (st & 1) * 32 + (swz % 64) / 2; }
DI int perm32(int rho) { const int n = rho >> 4, i = rho & 15; return 8 * (i >> 2) + 4 * n + (i & 3); }
struct Unit { int pm, pn; };
struct Gemm { const bf16_t* A; const bf16_t* Bt; int lda, ldb, K; };

struct StaticOrder {
    int nM, nN, nwg, G, c;
    DI void init(int M, int N, int G_, int c_) { nM = M / BM; nN = N / BM; nwg = nM * nN; G = G_; c = c_; }
    DI bool next(int i, Unit& u) const {
        const long Li = (long)i * G + c; if (c < 0 || Li >= nwg) return false;
        int wgid = (int)Li; { const int q = nwg / NXCD, r = nwg % NXCD, xcd = wgid % NXCD, off = wgid / NXCD; wgid = (xcd < r ? xcd * (q + 1) : r * (q + 1) + (xcd - r) * q) + off; }
        const int nig = WGM * nN, gid = wgid / nig, fm = gid * WGM, gsz = (nM - fm) < WGM ? (nM - fm) : WGM;
        u.pm = fm + ((wgid % nig) % gsz); u.pn = (wgid % nig) / gsz; return true;
    }
};
struct OrderS5Y { int G, c; DI bool next(int i, Unit& u) const { const int Li = i * G + c; if (c < 0 || Li >= 256) return false; const int g = Li >> 2; u.pm = 2 * g + ((Li >> 1) & 1); u.pn = 2 * g + (Li & 1); return true; } };
struct OrderS5X { int G, c; DI bool next(int i, Unit& u) const { const int Li = i * G + c; if (c < 0 || Li >= 128) return false; const int g = Li >> 1; u.pm = 2 * g + (Li & 1); u.pn = g; return true; } };

template <class Epi, class Sched>
DI void gemm_phase(LAS unsigned char* lds, const Gemm g, const Sched& S, const Epi& E) {
    const int tid = TID(), wid = __builtin_amdgcn_readfirstlane(tid >> 6), lane = tid & 63, wr = wid >> 2, wc = wid & 3, fr = lane & 15, fq = lane >> 4;
    const int K = g.K, nt = K / BK;
    unsigned voffA[2], voffB[2];
#pragma unroll
    for (int i = 0; i < 2; ++i) { int R, C; stage_rc(tid * 16 + i * 8192, R, C); const int Rb = Epi::PERM ? ((R & ~31) + perm32(R & 31)) : R;
        voffA[i] = (unsigned)(R * g.lda + C) * 2u; voffB[i] = (unsigned)(Rb * g.ldb + C) * 2u; }
    const size_t kstep = (size_t)(BK * 2);
    const size_t hstepA = (size_t)HALF * g.lda * 2, hstepB = (size_t)HALF * g.ldb * 2;
    const size_t tstepA = 2 * hstepA, tstepB = 2 * hstepB;
    const unsigned ldsw = (unsigned)wid * 1024u;
    const int aoff = lds_byte(wr * 64 + fr, fq * 8), boff = lds_byte(wc * 32 + fr, fq * 8);
#define PG8_SA(b, h) (((b) * 2 + (h)) * HTB)
#define PG8_SB(b, h) ((4 + (b) * 2 + (h)) * HTB)
#define PG8_STAGE(bufoff, gbase, voff) do { _Pragma("unroll") for (int _i = 0; _i < 2; ++_i) \
        __builtin_amdgcn_global_load_lds((const unsigned*)((const char*)(gbase) + (voff)[_i]), (LAS unsigned*)(lds + (bufoff) + ldsw + _i * 8192), 16, 0, 0); } while (0)
#define PG8_LDA(dst, b, h) do { _Pragma("unroll") for (int m = 0; m < 4; ++m) _Pragma("unroll") for (int k = 0; k < 2; ++k) dst[m][k] = *(const LAS bf16x8*)(lds + PG8_SA(b, h) + aoff + m * 2048 + k * 1024); } while (0)
#define PG8_LDB(dst, b, h) do { _Pragma("unroll") for (int n = 0; n < 2; ++n) _Pragma("unroll") for (int k = 0; k < 2; ++k) dst[n][k] = *(const LAS bf16x8*)(lds + PG8_SB(b, h) + boff + n * 2048 + k * 1024); } while (0)
#define PG8_MMA(ai, bj, At, Bt) do { __builtin_amdgcn_s_setprio(1); _Pragma("unroll") for (int m = 0; m < 4; ++m) _Pragma("unroll") for (int n = 0; n < 2; ++n) _Pragma("unroll") for (int k = 0; k < 2; ++k) \
        acc[ai][bj][m][n] = __builtin_amdgcn_mfma_f32_16x16x32_bf16(Bt[n][k], At[m][k], acc[ai][bj][m][n], 0, 0, 0); __builtin_amdgcn_s_setprio(0); } while (0)
#define PG8_WAIT_V(n) asm volatile("s_waitcnt vmcnt(" #n ")" ::: "memory")
#define PG8_WAIT_L(n) asm volatile("s_waitcnt lgkmcnt(" #n ")" ::: "memory")
#define PG8_BAR __builtin_amdgcn_s_barrier()
#define PG8_SCHED __builtin_amdgcn_sched_barrier(0)
    Unit cur, nxt; int ui = 0;
    if (!S.next(0, cur)) return;
    f32x4 acc[2][2][4][2];
#pragma unroll
    for (int a = 0; a < 2; ++a)
#pragma unroll
        for (int b = 0; b < 2; ++b)
#pragma unroll
            for (int m = 0; m < 4; ++m)
#pragma unroll
                for (int n = 0; n < 2; ++n) acc[a][b][m][n] = (f32x4){0.f, 0.f, 0.f, 0.f};
    bf16x8 At[4][2], B0[2][2], B1[2][2];
    const char* cA = (const char*)g.A + (size_t)cur.pm * tstepA; const char* cB = (const char*)g.Bt + (size_t)cur.pn * tstepB;
    PG8_STAGE(PG8_SB(0, 0), cB, voffB); PG8_STAGE(PG8_SA(0, 0), cA, voffA); PG8_STAGE(PG8_SB(0, 1), cB + hstepB, voffB); PG8_STAGE(PG8_SA(0, 1), cA + hstepA, voffA);
    if (wr == 1) PG8_BAR;
    PG8_WAIT_V(4); PG8_BAR;
    PG8_STAGE(PG8_SB(1, 0), cB + kstep, voffB); PG8_STAGE(PG8_SA(1, 0), cA + kstep, voffA); PG8_STAGE(PG8_SB(1, 1), cB + hstepB + kstep, voffB);
    PG8_WAIT_V(6); PG8_BAR;
    for (;;) {
        const bool has_next = S.next(ui + 1, nxt);
        const char* nA = has_next ? (const char*)g.A + (size_t)nxt.pm * tstepA : cA; const char* nB = has_next ? (const char*)g.Bt + (size_t)nxt.pn * tstepB : cB;
        for (int t = 0; t < nt; t += 2) {
            const bool last = (t == nt - 2);
            const char* a1 = cA + (size_t)(t + 1) * kstep;
            const char* a2 = last ? nA : cA + (size_t)(t + 2) * kstep; const char* b2 = last ? nB : cB + (size_t)(t + 2) * kstep;
            const char* a3 = a2 + kstep; const char* b3 = b2 + kstep;
            PG8_LDB(B0, 0, 0); PG8_SCHED; PG8_LDA(At, 0, 0); PG8_STAGE(PG8_SA(1, 1), a1 + hstepA, voffA);
            PG8_WAIT_L(8); PG8_BAR; PG8_WAIT_L(0); PG8_MMA(0, 0, At, B0); PG8_BAR; PG8_SCHED;
            PG8_LDB(B1, 0, 1); PG8_STAGE(PG8_SB(0, 0), b2, voffB);
            PG8_BAR; PG8_WAIT_L(0); PG8_MMA(0, 1, At, B1); PG8_BAR;
            PG8_LDA(At, 0, 1); PG8_STAGE(PG8_SA(0, 0), a2, voffA);
            PG8_BAR; PG8_WAIT_L(0); PG8_MMA(1, 0, At, B0); PG8_BAR; PG8_SCHED;
            PG8_STAGE(PG8_SB(0, 1), b2 + hstepB, voffB);
            PG8_WAIT_V(6); PG8_BAR; PG8_MMA(1, 1, At, B1); PG8_BAR;
            PG8_LDB(B0, 1, 0); PG8_SCHED; PG8_LDA(At, 1, 0); PG8_STAGE(PG8_SA(0, 1), a2 + hstepA, voffA);
            PG8_WAIT_L(8); PG8_BAR; PG8_WAIT_L(0); PG8_MMA(0, 0, At, B0); PG8_BAR; PG8_SCHED;
            PG8_LDB(B1, 1, 1); PG8_STAGE(PG8_SB(1, 0), b3, voffB);
            PG8_BAR; PG8_WAIT_L(0); PG8_MMA(0, 1, At, B1); PG8_BAR;
            PG8_LDA(At, 1, 1); PG8_STAGE(PG8_SA(1, 0), a3, voffA);
            PG8_BAR; PG8_WAIT_L(0); PG8_MMA(1, 0, At, B0); PG8_BAR; PG8_SCHED;
            PG8_STAGE(PG8_SB(1, 1), b3 + hstepB, voffB);
            PG8_WAIT_V(6); PG8_BAR; PG8_MMA(1, 1, At, B1); PG8_BAR;
        }
        E(acc, cur, wr, wc, fr, fq);
        if (!has_next) break;
#pragma unroll
        for (int a = 0; a < 2; ++a)
#pragma unroll
            for (int b = 0; b < 2; ++b)
#pragma unroll
                for (int m = 0; m < 4; ++m)
#pragma unroll
                    for (int n = 0; n < 2; ++n) acc[a][b][m][n] = (f32x4){0.f, 0.f, 0.f, 0.f};
        cur = nxt; cA = nA; cB = nB; ++ui;
    }
    PG8_WAIT_V(0);
    if (wr == 0) PG8_BAR;
    PG8_BAR;
#undef PG8_SA
#undef PG8_SB
#undef PG8_STAGE
#undef PG8_LDA
#undef PG8_LDB
#undef PG8_MMA
#undef PG8_WAIT_V
#undef PG8_WAIT_L
#undef PG8_BAR
#undef PG8_SCHED
}

typedef f32x4 Acc[2][2][4][2];
#define EPI_LOOP_PERM(...) _Pragma("unroll") for (int ai = 0; ai < 2; ++ai) _Pragma("unroll") for (int m = 0; m < 4; ++m) { const int row = u.pm * 256 + ai * 128 + wr * 64 + m * 16 + fr; \
    _Pragma("unroll") for (int bj = 0; bj < 2; ++bj) { const int c8 = bj * 128 + wc * 32 + 8 * fq; f32x4 v0 = acc[ai][bj][m][0], v1 = acc[ai][bj][m][1]; __VA_ARGS__ } }

struct EpiProj {
    static constexpr bool PERM = true;
    bf16_t *uperm, *qkv, *z, *sgs, *sgg; float* logit;
    DI void operator()(const Acc& acc, const Unit& u, int wr, int wc, int fr, int fq) const {
        const int pn = u.pn;
        if (pn < 4) {
            EPI_LOOP_PERM({ const int ch = pn * 256 + c8; *(u32x4*)(uperm + ((size_t)((ch >> 4) * 512 + (row >> 5)) * 640 + (row & 31) * 16 + (ch & 15))) = pack44(v0, v1); })
        } else if (pn < 16) {
            EPI_LOOP_PERM({ *(u32x4*)(qkv + (size_t)row * 3072 + (pn - 4) * 256 + c8) = pack44(v0, v1); })
        } else if (pn < 20) {
            EPI_LOOP_PERM({ *(u32x4*)(z + (size_t)row * 1024 + (pn - 16) * 256 + c8) = pack44(v0, v1); })
        } else if (pn < 36) {
            bf16_t* dst = pn < 28 ? sgs + (pn - 20) * 256 : sgg + (pn - 28) * 256;
            EPI_LOOP_PERM({ for (int j = 0; j < 4; ++j) { v0[j] = sigmoidf_(v0[j]); v1[j] = sigmoidf_(v1[j]); } *(u32x4*)(dst + (size_t)row * 2048 + c8) = pack44(v0, v1); })
        } else {
            EPI_LOOP_PERM({ if (bj == 0 && wc == 0 && fq < 2) { *(f32x4*)(logit + (size_t)row * 16 + 8 * fq) = v0; *(f32x4*)(logit + (size_t)row * 16 + 8 * fq + 4) = v1; } })
        }
    }
};
struct EpiXend {
    static constexpr bool PERM = false;
    float* xend;
    DI void operator()(const Acc& acc, const Unit& u, int wr, int wc, int fr, int fq) const {
#pragma unroll
        for (int ai = 0; ai < 2; ++ai)
#pragma unroll
            for (int m = 0; m < 4; ++m) { const int row = u.pm * 256 + ai * 128 + wr * 64 + m * 16 + fr;
#pragma unroll
                for (int n = 0; n < 2; ++n) *(f32x4*)(xend + (size_t)row * 128 + wc * 32 + 16 * n + 4 * fq) = acc[ai][0][m][n]; }
    }
};
struct EpiS5Y {
    static constexpr bool PERM = true;
    const bf16_t* uperm; const float* dskip; bf16_t* zs;
    DI void operator()(const Acc& acc, const Unit& u, int wr, int wc, int fr, int fq) const {
        const int g = u.pm >> 1, mt = u.pm & 1, nt = u.pn & 1;
#pragma unroll
        for (int ai = 0; ai < 2; ++ai)
#pragma unroll
            for (int m = 0; m < 4; ++m) { const int chunk = mt * 256 + ai * 128 + wr * 64 + m * 16 + fr;
#pragma unroll
                for (int bj = 0; bj < 2; ++bj) { const int n0 = nt * 256 + bj * 128 + wc * 32 + 8 * fq; const int t = n0 >> 4, ho0 = n0 & 15;
                    f32x4 v0 = acc[ai][bj][m][0], v1 = acc[ai][bj][m][1];
                    float uf[8]; unpack8(*(const u32x4*)(uperm + (size_t)(g * 512 + chunk) * 640 + n0), uf);
                    const f32x4 d0 = *(const f32x4*)(dskip + g * 16 + ho0), d1 = *(const f32x4*)(dskip + g * 16 + ho0 + 4);
                    for (int j = 0; j < 4; ++j) { v0[j] = gelu_tanh(v0[j] + d0[j] * uf[j]); v1[j] = gelu_tanh(v1[j] + d1[j] * uf[4 + j]); }
                    *(u32x4*)(zs + (size_t)(chunk * 32 + t) * 1024 + g * 16 + ho0) = pack44(v0, v1); } }
    }
};
struct EpiGlu {
    static constexpr bool PERM = true;
    const bf16_t* zs; const float* bias; bf16_t* y2;
    DI void operator()(const Acc& acc, const Unit& u, int wr, int wc, int fr, int fq) const {
        EPI_LOOP_PERM({ const int col = u.pn * 256 + c8; float zf[8]; unpack8(*(const u32x4*)(zs + (size_t)row * 1024 + col), zf);
            const f32x4 b0 = *(const f32x4*)(bias + col), b1 = *(const f32x4*)(bias + col + 4);
            for (int j = 0; j < 4; ++j) { v0[j] = zf[j] * sigmoidf_(v0[j] + b0[j]); v1[j] = zf[4 + j] * sigmoidf_(v1[j] + b1[j]); }
            *(u32x4*)(y2 + (size_t)row * 1024 + col) = pack44(v0, v1); })
    }
};
template <int SECOND> struct EpiUp {
    static constexpr bool PERM = true;
    const bf16_t* gate; const bf16_t* t1in; bf16_t* dst;
    DI void operator()(const Acc& acc, const Unit& u, int wr, int wc, int fr, int fq) const {
        EPI_LOOP_PERM({ const size_t o = (size_t)row * 2048 + u.pn * 256 + c8; float gf[8]; unpack8(*(const u32x4*)(gate + o), gf);
            float tf[8]; if (SECOND) unpack8(*(const u32x4*)(t1in + o), tf); else { for (int j = 0; j < 8; ++j) tf[j] = 0.f; }
            for (int j = 0; j < 4; ++j) { v0[j] = tf[j] + gf[j] * v0[j]; v1[j] = tf[4 + j] + gf[4 + j] * v1[j]; }
            *(u32x4*)(dst + o) = pack44(v0, v1); })
    }
};
struct EpiResid {
    static constexpr bool PERM = false;
    const float* xin; const float* gate; float* out;
    DI void operator()(const Acc& acc, const Unit& u, int wr, int wc, int fr, int fq) const {
#pragma unroll
        for (int ai = 0; ai < 2; ++ai)
#pragma unroll
            for (int m = 0; m < 4; ++m) { const int row = u.pm * 256 + ai * 128 + wr * 64 + m * 16 + fr;
#pragma unroll
                for (int bj = 0; bj < 2; ++bj)
#pragma unroll
                    for (int n = 0; n < 2; ++n) { const int col = u.pn * 256 + bj * 128 + wc * 32 + 16 * n + 4 * fq; const size_t o = (size_t)row * 2048 + col;
                        const f32x4 xv = *(const f32x4*)(xin + o), gv = *(const f32x4*)(gate + col);
                        *(f32x4*)(out + o) = ALPHA * xv + gv * acc[ai][bj][m][n]; } }
    }
};
struct EpiSwiglu {
    static constexpr bool PERM = true;
    bf16_t* a;
    DI void operator()(const Acc& acc, const Unit& u, int wr, int wc, int fr, int fq) const {
#pragma unroll
        for (int ai = 0; ai < 2; ++ai)
#pragma unroll
            for (int m = 0; m < 4; ++m) { const int row = u.pm * 256 + ai * 128 + wr * 64 + m * 16 + fr;
                f32x4 g0 = acc[ai][0][m][0], g1 = acc[ai][0][m][1]; const f32x4 u0 = acc[ai][1][m][0], u1 = acc[ai][1][m][1];
                for (int j = 0; j < 4; ++j) { g0[j] = siluf_(g0[j]) * u0[j]; g1[j] = siluf_(g1[j]) * u1[j]; }
                *(u32x4*)(a + (size_t)row * FH + u.pn * 128 + wc * 32 + 8 * fq) = pack44(g0, g1); }
    }
};
}

template <int MODE> DI int rowmap(int n) {
    if (MODE == 1) return n < 5120 ? n : (n < 5136 ? 9216 + (n - 5120) : n - 16);
    if (MODE == 2) { if (n < 5632) return (n >> 7) * 256 + (n & 127); const int m = n - 5632; return (m >> 7) * 256 + 128 + (m & 127); }
    return n;
}
template <int MODE> DI void transpose_job(LAS unsigned char* lds, const float* src, int K, int N, bf16_t* dst) {
    LAS float* tl = (LAS float*)lds;
    const int tid = TID(), tn = (N + 63) >> 6, tk = K >> 6, ntile = tn * tk;
    for (int t = BID(); t < ntile; t += GDIM()) {
        const int k0 = (t / tn) * 64, n0 = (t % tn) * 64;
#pragma unroll
        for (int i = 0; i < 2; ++i) { const int kk = (tid >> 4) + 32 * i, nn = (tid & 15) * 4;
            f32x4 v = {0.f, 0.f, 0.f, 0.f}; if (n0 + nn < N) v = *(const f32x4*)(src + (size_t)(k0 + kk) * N + n0 + nn);
            tl[kk * 65 + nn] = v[0]; tl[kk * 65 + nn + 1] = v[1]; tl[kk * 65 + nn + 2] = v[2]; tl[kk * 65 + nn + 3] = v[3]; }
        lds_barrier();
        { const int n = tid >> 3, ko = (tid & 7) * 8;
          if (n0 + n < N) { float f[8];
#pragma unroll
              for (int j = 0; j < 8; ++j) f[j] = tl[(ko + j) * 65 + n];
              *(u32x4*)(dst + (size_t)rowmap<MODE>(n0 + n) * K + k0 + ko) = pack8(f); } }
        lds_barrier();
    }
}

DI void phase_weights(LAS unsigned char* lds, PP p, int l) {
    unsigned char* ws = p->ws;
    transpose_job<1>(lds, p->in[4] + (size_t)l * 2048 * 9232, 2048, 9232, (bf16_t*)(ws + O_WIN));
    transpose_job<0>(lds, p->in[13] + (size_t)l * 1024 * 1024, 1024, 1024, (bf16_t*)(ws + O_WGLU));
    transpose_job<0>(lds, p->in[19] + (size_t)l * 1024 * 2048, 1024, 2048, (bf16_t*)(ws + O_WUPS));
    transpose_job<0>(lds, p->in[20] + (size_t)l * 1024 * 2048, 1024, 2048, (bf16_t*)(ws + O_WUPG));
    transpose_job<0>(lds, p->in[21] + (size_t)l * 2048 * 2048, 2048, 2048, (bf16_t*)(ws + O_WOUT));
    transpose_job<2>(lds, p->in[24] + (size_t)l * 2048 * 11264, 2048, 11264, (bf16_t*)(ws + O_WF1));
    transpose_job<0>(lds, p->in[25] + (size_t)l * 5632 * 2048, 5632, 2048, (bf16_t*)(ws + O_WF2));
    { u32x4* z = (u32x4*)(ws + O_WIN + (size_t)9232 * 2048 * 2); const int nz = 240 * 2048 * 2 / 16;
      for (int i = BID() * NTHR + TID(); i < nz; i += GDIM() * NTHR) z[i] = (u32x4){0u, 0u, 0u, 0u}; }
}

DI void phase_mod(LAS unsigned char* lds, PP p) {
    LAS float* red = (LAS float*)lds;
    const int tid = TID(), col = tid & 63, kp = tid >> 6;
    const float* c = p->in[1];
    float* mod = (float*)(p->ws + O_MOD);
    for (int u = BID(); u < 384; u += GDIM()) {
        const int l = u / 192, c0 = (u % 192) * 64;
        const float* w = p->in[2] + (size_t)l * 2048 * 12288 + c0 + col;
        float s = 0.f;
        for (int k = kp * 256; k < kp * 256 + 256; ++k) { const float cv = c[k]; s += (cv / (1.f + expf(-cv))) * w[(size_t)k * 12288]; }
        red[kp * 64 + col] = s;
        __syncthreads();
        if (tid < 64) { float t = 0.f; for (int i = 0; i < 8; ++i) t += red[i * 64 + tid]; mod[l * 12288 + c0 + tid] = t + p->in[3][l * 12288 + c0 + tid]; }
        __syncthreads();
    }
}

DI void phase_s5pre(LAS unsigned char* lds, PP p, int l) {
    LAS float* apr = (LAS float*)lds;
    LAS float* api = apr + 33 * 64;
    LAS float* bbr = api + 33 * 64;
    LAS float* bbi = bbr + 1024;
    LAS float* ccr = bbi + 1024;
    LAS float* cci = ccr + 1024;
    LAS float* kt = cci + 1024;
    const int tid = TID();
    bf16_t* bt2 = (bf16_t*)(p->ws + O_BT2); bf16_t* m2 = (bf16_t*)(p->ws + O_M2); float* a32 = (float*)(p->ws + O_A32);
    for (int g = BID(); g < 64; g += GDIM()) {
        const float dt = expf(p->in[7][l * 64 + g]);
        for (int id = tid; id < 33 * 64; id += NTHR) { const int pp = id & 63, j = id >> 6;
            const float lr = p->in[5][(l * 64 + g) * 64 + pp], li = p->in[6][(l * 64 + g) * 64 + pp];
            const float mg = expf(lr * dt * (float)j), an = li * dt * (float)j; float sn, cs; sincosf(an, &sn, &cs); const float re = mg * cs, im = mg * sn;
            apr[j * 64 + pp] = re; api[j * 64 + pp] = im;
            if (j == 32) { a32[(g * 64 + pp) * 2] = re; a32[(g * 64 + pp) * 2 + 1] = im; } }
        for (int id = tid; id < 1024; id += NTHR) { const int pp = id >> 4, hi = id & 15;
            const float lr = p->in[5][(l * 64 + g) * 64 + pp], li = p->in[6][(l * 64 + g) * 64 + pp];
            const float mg = expf(lr * dt), an = li * dt; float sn, cs; sincosf(an, &sn, &cs); const float nr = mg * cs - 1.0f, ni = mg * sn, den = lr * lr + li * li;
            const float fr = (nr * lr + ni * li) / den, fi = (ni * lr - nr * li) / den;
            const size_t bo = ((size_t)(l * 64 + g) * 64 + pp) * 16 + hi; const float br = p->in[8][bo], bi = p->in[9][bo];
            bbr[id] = fr * br - fi * bi; bbi[id] = fr * bi + fi * br;
            const int ho = id >> 6, p2 = id & 63; const size_t co = ((size_t)(l * 64 + g) * 16 + ho) * 64 + p2;
            ccr[id] = p->in[10][co]; cci[id] = p->in[11][co]; }
        __syncthreads();
        for (int id = tid; id < 32 * 256; id += NTHR) { const int j = id >> 8, ho = (id >> 4) & 15, hi = id & 15; float s = 0.f;
            for (int pp = 0; pp < 64; ++pp) { const float ar = apr[j * 64 + pp], ai = api[j * 64 + pp], br = bbr[pp * 16 + hi], bi = bbi[pp * 16 + hi];
                const float wr_ = ar * br - ai * bi, wi_ = ar * bi + ai * br; s += ccr[ho * 64 + pp] * wr_ - cci[ho * 64 + pp] * wi_; }
            kt[id] = s; }
        __syncthreads();
        for (int id = tid; id < 512 * 80; id += NTHR) { const int n = id / 80, oc = id % 80, t = n >> 4, ho = n & 15; float f[8];
            if (oc < 64) { const int s = oc >> 1, hi0 = (oc & 1) * 8;
                for (int i = 0; i < 8; ++i) f[i] = (s <= t) ? kt[(t - s) * 256 + ho * 16 + hi0 + i] : 0.f;
            } else { for (int i = 0; i < 8; ++i) { const int cc = (oc - 64) * 8 + i, ri = cc >> 6, pp = cc & 63;
                const float ar = apr[(t + 1) * 64 + pp], ai = api[(t + 1) * 64 + pp], cr = ccr[ho * 64 + pp], ci = cci[ho * 64 + pp];
                f[i] = ri == 0 ? (cr * ar - ci * ai) : -(cr * ai + ci * ar); } }
            *(u32x4*)(bt2 + ((size_t)g * 512 + n) * 640 + oc * 8) = pack8(f); }
        for (int id = tid; id < 256 * 64; id += NTHR) { const int rr = id >> 6, oc = id & 63; float f[8];
            if (rr < 128) { const int ri = rr >> 6, pp = rr & 63, s = oc >> 1, hi0 = (oc & 1) * 8; const float ar = apr[(31 - s) * 64 + pp], ai = api[(31 - s) * 64 + pp];
                for (int i = 0; i < 8; ++i) { const float br = bbr[pp * 16 + hi0 + i], bi = bbi[pp * 16 + hi0 + i]; f[i] = ri == 0 ? (ar * br - ai * bi) : (ar * bi + ai * br); }
            } else { for (int i = 0; i < 8; ++i) f[i] = 0.f; }
            *(u32x4*)(m2 + ((size_t)g * 256 + rr) * 512 + oc * 8) = pack8(f); }
        __syncthreads();
    }
}

DI float wave_sum(float v) {
#pragma unroll
    for (int o = 32; o >= 1; o >>= 1) v += __shfl_xor(v, o);
    return v;
}
template <bool FIRST, bool SECOND>
DI void phase_ln(const float* src, const float* g, const float* b, float* dst1, const float* sh, const float* sc, bf16_t* dsth) {
    const int wid = TID() >> 6, lane = TID() & 63;
    for (int row = BID() * 8 + wid; row < L; row += GDIM() * 8) {
        float v[4][8];
#pragma unroll
        for (int i = 0; i < 4; ++i) { const f32x4 a = *(const f32x4*)(src + (size_t)row * DM + i * 512 + lane * 8), c = *(const f32x4*)(src + (size_t)row * DM + i * 512 + lane * 8 + 4);
            v[i][0] = a[0]; v[i][1] = a[1]; v[i][2] = a[2]; v[i][3] = a[3]; v[i][4] = c[0]; v[i][5] = c[1]; v[i][6] = c[2]; v[i][7] = c[3]; }
        if (FIRST) {
            float s = 0.f;
#pragma unroll
            for (int i = 0; i < 4; ++i) for (int k = 0; k < 8; ++k) s += v[i][k];
            const float mu = wave_sum(s) * (1.f / DM); float q = 0.f;
#pragma unroll
            for (int i = 0; i < 4; ++i) for (int k = 0; k < 8; ++k) { const float d = v[i][k] - mu; q += d * d; }
            const float rs = rsqrtf(wave_sum(q) * (1.f / DM) + 1e-5f);
#pragma unroll
            for (int i = 0; i < 4; ++i) { const int c0 = i * 512 + lane * 8;
                const f32x4 g0 = *(const f32x4*)(g + c0), g1 = *(const f32x4*)(g + c0 + 4), b0 = *(const f32x4*)(b + c0), b1 = *(const f32x4*)(b + c0 + 4);
                for (int k = 0; k < 4; ++k) { v[i][k] = (v[i][k] - mu) * rs * g0[k] + b0[k]; v[i][4 + k] = (v[i][4 + k] - mu) * rs * g1[k] + b1[k]; }
                *(f32x4*)(dst1 + (size_t)row * DM + c0) = (f32x4){v[i][0], v[i][1], v[i][2], v[i][3]};
                *(f32x4*)(dst1 + (size_t)row * DM + c0 + 4) = (f32x4){v[i][4], v[i][5], v[i][6], v[i][7]}; }
        }
        if (SECOND) {
            float s = 0.f;
#pragma unroll
            for (int i = 0; i < 4; ++i) for (int k = 0; k < 8; ++k) s += v[i][k];
            const float mu = wave_sum(s) * (1.f / DM); float q = 0.f;
#pragma unroll
            for (int i = 0; i < 4; ++i) for (int k = 0; k < 8; ++k) { const float d = v[i][k] - mu; q += d * d; }
            const float rs = rsqrtf(wave_sum(q) * (1.f / DM) + 1e-5f);
#pragma unroll
            for (int i = 0; i < 4; ++i) { const int c0 = i * 512 + lane * 8; float f[8];
                const f32x4 s0 = *(const f32x4*)(sc + c0), s1 = *(const f32x4*)(sc + c0 + 4), h0 = *(const f32x4*)(sh + c0), h1 = *(const f32x4*)(sh + c0 + 4);
                for (int k = 0; k < 4; ++k) { f[k] = (v[i][k] - mu) * rs * (1.f + s0[k]) + h0[k]; f[4 + k] = (v[i][4 + k] - mu) * rs * (1.f + s1[k]) + h1[k]; }
                *(u32x4*)(dsth + (size_t)row * DM + c0) = pack8(f); }
        }
    }
}

DI void phase_carry(PP p, int bid) {
    const int id = bid * NTHR + TID();
    if (id >= 4096) return;
    const int g = id >> 6, pp = id & 63;
    const float* a32 = (const float*)(p->ws + O_A32); const float* xe = (const float*)(p->ws + O_XEND) + (size_t)g * 512 * 128 + pp;
    bf16_t* up = (bf16_t*)(p->ws + O_E) + (size_t)g * 512 * 640 + 512 + pp;
    const float ar = a32[id * 2], ai = a32[id * 2 + 1];
    float xr = 0.f, xi = 0.f;
#pragma unroll 32
    for (int c = 0; c < 512; ++c) {
        up[(size_t)c * 640] = f2bf(xr); up[(size_t)c * 640 + 64] = f2bf(xi);
        const float er = xe[(size_t)c * 128], ei = xe[(size_t)c * 128 + 64];
        const float nr = ar * xr - ai * xi + er, ni = ar * xi + ai * xr + ei; xr = nr; xi = ni;
    }
}

constexpr int QN_O = 0, KN_O = 17408, XTK_O = 34816, XTV_O = 53248, KT2_O = 71680, TIMG_O = 90112, MM_O = 99328, AT_O = 116736, SC_O = 134144;
DI void gdn_intra(LAS unsigned char* lds, PP p, int l, int item) {
    { unsigned lb = (unsigned)(size_t)lds; asm volatile("" : "+v"(lb)); lds = (LAS unsigned char*)lb; }
    const int tid = TID(), w = tid >> 6, lane = tid & 63, r = lane & 31, h = lane >> 5;
    const int hd = item >> 8, n = item & 255, tok0 = n * 64;
    LAS bf16_t* Qn = (LAS bf16_t*)(lds + QN_O); LAS bf16_t* Kn = (LAS bf16_t*)(lds + KN_O);
    LAS bf16_t* XTk = (LAS bf16_t*)(lds + XTK_O); LAS bf16_t* XTv = (LAS bf16_t*)(lds + XTV_O); LAS bf16_t* KT2 = (LAS bf16_t*)(lds + KT2_O);
    LAS bf16_t* Timg = (LAS bf16_t*)(lds + TIMG_O); LAS float* Mm = (LAS float*)(lds + MM_O); LAS float* At = (LAS float*)(lds + AT_O);
    LAS float* scb = (LAS float*)(lds + SC_O); LAS float* scg = scb + 64; LAS float* sce = scb + 128; LAS float* scl = scb + 192;
    const float* logit = (const float*)(p->ws + O_LOG);
    const bf16_t* qkv = (const bf16_t*)(p->ws + O_QKV);
    unsigned char* fb = p->ws + O_A + (size_t)item * FRAG_ITEM;
    unsigned char* ub = p->ws + O_UFR + (size_t)item * UFR_ITEM;
    if (tid < 64) {
        const int tok = tok0 + tid;
        const float bl = logit[(size_t)tok * 16 + hd], al = logit[(size_t)tok * 16 + 8 + hd];
        const float beta = 1.f / (1.f + __expf(-bl));
        const float xx = al + p->in[17][l * 8 + hd];
        const float ex = __expf(fminf(xx, 20.f));
        const float sp = xx > 20.f ? xx : (ex < 0.05f ? ex * (1.f - ex * (0.5f - ex * (0.33333333f - ex * 0.25f))) : __logf(1.f + ex));
        float gc = -__expf(p->in[16][l * 8 + hd]) * sp;
#pragma unroll
        for (int off = 1; off < 64; off <<= 1) { const float t = __shfl_up(gc, off); if (tid >= off) gc += t; }
        const float gl = __shfl(gc, 63);
        scb[tid] = beta; scg[tid] = gc; sce[tid] = __expf(gc); scl[tid] = __expf(gl - gc);
        if (tid == 0) ((float*)(p->ws + O_GL))[hd * 256 + n] = __expf(gl);
    }
    lds_barrier();
    const float* cw = p->in[15] + (size_t)l * 4 * 3072;
#pragma unroll 1
    for (int mat = 0; mat < 3; ++mat) {
#pragma unroll 1
        for (int it = 0; it < 2; ++it) {
            const int id = tid + NTHR * it, j = id >> 4, o = id & 15, col = mat * 1024 + hd * 128 + o * 8;
            float a[8];
#pragma unroll
            for (int i = 0; i < 8; ++i) a[i] = 0.f;
#pragma unroll
            for (int kk = 0; kk < 4; ++kk) { const int t = tok0 + j - 3 + kk;
                if (t >= 0) { float x[8]; unpack8(*(const u32x4*)(qkv + (size_t)t * 3072 + col), x);
                    const f32x4 w0 = *(const f32x4*)(cw + kk * 3072 + col), w1 = *(const f32x4*)(cw + kk * 3072 + col + 4);
                    for (int i = 0; i < 4; ++i) { a[i] += w0[i] * x[i]; a[4 + i] += w1[i] * x[4 + i]; } } }
#pragma unroll
            for (int i = 0; i < 8; ++i) a[i] = a[i] / (1.f + __expf(-a[i]));
            if (mat < 2) {
                float ss = 0.f;
#pragma unroll
                for (int i = 0; i < 8; ++i) ss += a[i] * a[i];
                ss += __shfl_xor(ss, 1); ss += __shfl_xor(ss, 2); ss += __shfl_xor(ss, 4); ss += __shfl_xor(ss, 8);
                const float sc = rsqrtf(ss + 1e-6f) * (mat == 0 ? 0.08838834764831845f : 1.f);
#pragma unroll
                for (int i = 0; i < 8; ++i) a[i] *= sc;
            }
            if (mat == 0) {
                *(LAS u32x4*)(Qn + j * 136 + o * 8) = pack8(a);
                const float eg = sce[j]; const int ct = j >> 5, s = o >> 1, part = o & 1;
                unsigned char* q0 = fb + 16384 + ((size_t)((ct * 8 + s) * 64 + (j & 31))) * 16 + 8 * part;
                u32x2 lo, hi2; lo.x = pk2(a[0] * eg, a[1] * eg); lo.y = pk2(a[2] * eg, a[3] * eg); hi2.x = pk2(a[4] * eg, a[5] * eg); hi2.y = pk2(a[6] * eg, a[7] * eg);
                *(u32x2*)q0 = lo; *(u32x2*)(q0 + 32 * 16) = hi2;
            } else if (mat == 1) {
                *(LAS u32x4*)(Kn + j * 136 + o * 8) = pack8(a);
                const float f1 = scb[j] * sce[j], f2 = scl[j];
#pragma unroll
                for (int i = 0; i < 8; ++i) { XTk[(o * 8 + i) * 72 + j] = f2bf(a[i] * f1); KT2[(o * 8 + i) * 72 + j] = f2bf(a[i] * f2); }
            } else {
                const float f1 = scb[j];
#pragma unroll
                for (int i = 0; i < 8; ++i) XTv[(o * 8 + i) * 72 + j] = f2bf(a[i] * f1);
            }
        }
    }
    lds_barrier();
    {
        const int isq = w >> 2, it = (w & 3) >> 1, jt = w & 1;
        LAS bf16_t* Ai = isq ? Qn : Kn;
        f32x16 acc; for (int i = 0; i < 16; ++i) acc[i] = 0.f;
#pragma unroll
        for (int s = 0; s < 8; ++s) { const bf16x8 a = *(const LAS bf16x8*)(Ai + (32 * it + r) * 136 + 16 * s + 8 * h), b = *(const LAS bf16x8*)(Kn + (32 * jt + r) * 136 + 16 * s + 8 * h);
            acc = MFMA32(a, b, acc); }
        const int col = 32 * jt + r; const float gcc = scg[col];
#pragma unroll
        for (int i = 0; i < 16; ++i) { const int row = 32 * it + crow(i, h);
            if (isq) At[row * 68 + col] = (row >= col) ? acc[i] * __expf(scg[row] - gcc) : 0.f;
            else Mm[row * 68 + col] = (row > col) ? scb[row] * acc[i] * __expf(scg[row] - gcc) : 0.f; }
    }
    lds_barrier();
    if (w == 0) {
        float t[64]; const float lanef = (float)lane;
#pragma unroll
        for (int i = 0; i < 64; ++i) {
            float a0 = fmaxf(0.f, 1.f - fabsf(lanef - (float)i)), a1 = 0.f;
#pragma unroll
            for (int j4 = 0; j4 < (i + 3) / 4; ++j4) { const f32x4 mv = *(const LAS f32x4*)(Mm + i * 68 + j4 * 4);
#pragma unroll
                for (int jj = 0; jj < 4; ++jj) { const int j = j4 * 4 + jj; if (j < i) { if (jj & 1) a1 -= mv[jj] * t[j]; else a0 -= mv[jj] * t[j]; } } }
            t[i] = a0 + a1;
            if ((i & 3) == 3) asm volatile("" ::: "memory");
        }
#pragma unroll
        for (int i = 0; i < 64; ++i) Timg[i * 72 + lane] = f2bf(t[i]);
    } else {
        for (int id = tid - 64; id < 1536; id += 448) {
            const int ln = id & 63, rr = ln & 31, hh = ln >> 5;
            if (id < 1024) { const int f = id >> 6, dt = f >> 2, s = f & 3; const int d = 32 * dt + rr;
                const u32x2 lo = *(const LAS u32x2*)(KT2 + d * 72 + 16 * s + 4 * hh), hi2 = *(const LAS u32x2*)(KT2 + d * 72 + 16 * s + 8 + 4 * hh);
                *(u32x4*)(fb + 40960 + (size_t)(f * 64 + ln) * 16) = (u32x4){lo.x, lo.y, hi2.x, hi2.y};
            } else { const int f = (id - 1024) >> 6, ct = f >> 2, s = f & 3; const int row = 32 * ct + rr;
                const f32x4 lo = *(const LAS f32x4*)(At + row * 68 + 16 * s + 4 * hh), hi2 = *(const LAS f32x4*)(At + row * 68 + 16 * s + 8 + 4 * hh);
                *(u32x4*)(fb + 32768 + (size_t)(f * 64 + ln) * 16) = pack44(lo, hi2); }
        }
    }
    lds_barrier();
    {
        const int ct = w >> 2, et = w & 3;
        f32x16 acc; for (int i = 0; i < 16; ++i) acc[i] = 0.f;
#pragma unroll
        for (int s = 0; s < 4; ++s) { const bf16x8 a = *(const LAS bf16x8*)(Timg + (32 * ct + r) * 72 + 16 * s + 8 * h), b = *(const LAS bf16x8*)(XTv + (32 * et + r) * 72 + 16 * s + 8 * h);
            acc = MFMA32(a, b, acc); }
        float* ud = (float*)(ub + (size_t)(ct * 4 + et) * 4096 + lane * 64);
#pragma unroll
        for (int q = 0; q < 4; ++q) *(f32x4*)(ud + 4 * q) = (f32x4){acc[4 * q], acc[4 * q + 1], acc[4 * q + 2], acc[4 * q + 3]};
        const int dt = w >> 1, c2 = w & 1;
        f32x16 ac2; for (int i = 0; i < 16; ++i) ac2[i] = 0.f;
#pragma unroll
        for (int s = 0; s < 4; ++s) { const bf16x8 a = *(const LAS bf16x8*)(XTk + (32 * dt + r) * 72 + 16 * s + 8 * h), b = *(const LAS bf16x8*)(Timg + (32 * c2 + r) * 72 + 16 * s + 8 * h);
            ac2 = MFMA32(a, b, ac2); }
#pragma unroll
        for (int sp = 0; sp < 2; ++sp) { u32x4 wv; wv.x = pk2(ac2[8 * sp], ac2[8 * sp + 1]); wv.y = pk2(ac2[8 * sp + 2], ac2[8 * sp + 3]); wv.z = pk2(ac2[8 * sp + 4], ac2[8 * sp + 5]); wv.w = pk2(ac2[8 * sp + 6], ac2[8 * sp + 7]);
            *(u32x4*)(fb + (size_t)((c2 * 8 + 2 * dt + sp) * 64 + lane) * 16) = wv; }
    }
    lds_barrier();
}

DI void gdn_scan(LAS unsigned char* lds, PP p, int wg) {
    const int tid = TID(), w = tid >> 6, lane = tid & 63, r = lane & 31, h = lane >> 5;
    const int hd = wg >> 1, cb = wg & 1, rt = w >> 1, et = w & 1;
    LAS u32x4* Simg = (LAS u32x4*)lds;
    LAS u32x4* Vimg = (LAS u32x4*)(lds + 16384);
    f32x16 S; for (int i = 0; i < 16; ++i) S[i] = 0.f;
    Simg[((2 * rt) * 2 + et) * 64 + lane] = (u32x4){0u, 0u, 0u, 0u}; Simg[((2 * rt + 1) * 2 + et) * 64 + lane] = (u32x4){0u, 0u, 0u, 0u};
    lds_barrier();
    const unsigned char* fb = p->ws + O_A + (size_t)(hd * 256) * FRAG_ITEM;
    const unsigned char* ub = p->ws + O_UFR + (size_t)(hd * 256) * UFR_ITEM;
    const float* GL = (const float*)(p->ws + O_GL) + hd * 256;
    bf16_t* obf = (bf16_t*)(p->ws + O_OBF);
    const size_t a1off = (rt < 2 ? 0 : 16384) + (size_t)((rt & 1) * 8) * 1024 + lane * 16;
    const size_t ktoff = 40960 + (size_t)(rt * 4) * 1024 + lane * 16;
    const unsigned char* xbase = rt >= 2 ? fb + 32768 + (size_t)((rt & 1) * 4) * 1024 + lane * 16 : ub + (size_t)((rt & 1) * 4 + 2 * cb + et) * 4096 + lane * 64;
    const size_t xitem = rt >= 2 ? FRAG_ITEM : UFR_ITEM, xstep = rt >= 2 ? 1024 : 16;
#define SCAN_LOAD_A1(A1_, n_) do { const unsigned char* f_ = fb + (size_t)(n_) * FRAG_ITEM + a1off; \
        _Pragma("unroll") for (int s = 0; s < 8; ++s) A1_[s] = *(const bf16x8*)(f_ + s * 1024); } while (0)
#define SCAN_LOAD_X(KT_, X_, n_) do { const unsigned char* f_ = fb + (size_t)(n_) * FRAG_ITEM + ktoff; const unsigned char* x_ = xbase + (size_t)(n_) * xitem; \
        _Pragma("unroll") for (int s = 0; s < 4; ++s) { KT_[s] = *(const bf16x8*)(f_ + s * 1024); X_[s] = *(const u32x4*)(x_ + s * xstep); } } while (0)
#define SCAN_STEP(n_, A1_, KT_, X_) do { \
        const int nq_ = (n_); const float gsel_ = nq_ < 64 ? glr0 : (nq_ < 128 ? glr1 : (nq_ < 192 ? glr2 : glr3)); \
        const float gl = __int_as_float(__builtin_amdgcn_readlane(__float_as_int(gsel_), nq_ & 63)); const int n2_ = (n_) + 2 < 256 ? (n_) + 2 : 255; \
        f32x16 acc; for (int i = 0; i < 16; ++i) acc[i] = 0.f; \
        _Pragma("unroll") for (int s = 0; s < 8; ++s) { const bf16x8 b = __builtin_bit_cast(bf16x8, Simg[(s * 2 + et) * 64 + lane]); acc = MFMA32(A1_[s], b, acc); } \
        SCAN_LOAD_A1(A1_, n2_); \
        if (rt < 2) { \
            _Pragma("unroll") for (int sp = 0; sp < 2; ++sp) { float v[8]; \
                _Pragma("unroll") for (int j = 0; j < 8; ++j) v[j] = __builtin_bit_cast(f32x4, X_[(8 * sp + j) >> 2])[(8 * sp + j) & 3] - acc[8 * sp + j]; \
                Vimg[((2 * rt + sp) * 2 + et) * 64 + lane] = pack8(v); } } \
        lds_barrier(); \
        _Pragma("unroll") for (int i = 0; i < 16; ++i) S[i] *= gl; \
        _Pragma("unroll") for (int s = 0; s < 4; ++s) { const bf16x8 b = __builtin_bit_cast(bf16x8, Vimg[(s * 2 + et) * 64 + lane]); S = MFMA32(KT_[s], b, S); \
            if (rt >= 2) acc = MFMA32(__builtin_bit_cast(bf16x8, X_[s]), b, acc); } \
        SCAN_LOAD_X(KT_, X_, n2_); \
        if (rt >= 2) { const int col = hd * 128 + 64 * cb + 32 * et + r; \
            _Pragma("unroll") for (int i = 0; i < 16; ++i) { const int tok = 64 * (n_) + 32 * (rt - 2) + crow(i, h); obf[(size_t)tok * 1024 + col] = f2bf(acc[i]); } } \
        _Pragma("unroll") for (int sp = 0; sp < 2; ++sp) { float v[8]; \
            _Pragma("unroll") for (int j = 0; j < 8; ++j) v[j] = S[8 * sp + j]; \
            Simg[((2 * rt + sp) * 2 + et) * 64 + lane] = pack8(v); } \
        lds_barrier(); } while (0)
    bf16x8 A1a[8], A1b[8], KTa[4], KTb[4]; u32x4 Xa[4], Xb[4];
    const float glr0 = GL[lane], glr1 = GL[64 + lane], glr2 = GL[128 + lane], glr3 = GL[192 + lane];
    SCAN_LOAD_A1(A1a, 0); SCAN_LOAD_X(KTa, Xa, 0); SCAN_LOAD_A1(A1b, 1); SCAN_LOAD_X(KTb, Xb, 1);
    for (int n = 0; n < 256; n += 2) {
        SCAN_STEP(n, A1a, KTa, Xa);
        SCAN_STEP(n + 1, A1b, KTb, Xb);
    }
#undef SCAN_LOAD_A1
#undef SCAN_LOAD_X
#undef SCAN_STEP
}

DI void phase_normgate(PP p, int l, int nblk, int bid) {
    bf16_t* obf = (bf16_t*)(p->ws + O_OBF); const bf16_t* z = (const bf16_t*)(p->ws + O_Z);
    const int o8 = TID() & 15;
    const f32x4 w0 = *(const f32x4*)(p->in[18] + l * 128 + o8 * 8), w1 = *(const f32x4*)(p->in[18] + l * 128 + o8 * 8 + 4);
    for (int grp = bid * 32 + (TID() >> 4); grp < L * 8; grp += nblk * 32) {
        const size_t base = (size_t)(grp >> 3) * 1024 + (grp & 7) * 128 + o8 * 8;
        float o[8], zz[8]; unpack8(*(const u32x4*)(obf + base), o); unpack8(*(const u32x4*)(z + base), zz);
        float ss = 0.f;
#pragma unroll
        for (int i = 0; i < 8; ++i) ss += o[i] * o[i];
        ss += __shfl_xor(ss, 1); ss += __shfl_xor(ss, 2); ss += __shfl_xor(ss, 4); ss += __shfl_xor(ss, 8);
        const float sc = rsqrtf(ss * (1.f / 128.f) + 1e-6f);
#pragma unroll
        for (int i = 0; i < 4; ++i) { o[i] = o[i] * sc * w0[i] * siluf_(zz[i]); o[4 + i] = o[4 + i] * sc * w1[i] * siluf_(zz[4 + i]); }
        *(u32x4*)(obf + base) = pack8(o);
    }
}

__global__ void __launch_bounds__(512, 2) hybrid_fwd(Params p_arg) {
    extern __shared__ __attribute__((aligned(16))) unsigned char shm[];
    LAS unsigned char* lds = (LAS unsigned char*)shm;
    cg::grid_group grid = cg::this_grid();
    using namespace pg8;
    const unsigned my_xcc = xcc_id();
    if (__builtin_amdgcn_workitem_id_x() == 0) __hip_atomic_fetch_add((unsigned*)(p_arg.ws + O_BAR) + 512 + 64 * my_xcc, 1u, __ATOMIC_RELAXED, __HIP_MEMORY_SCOPE_AGENT);
    unsigned nx_mine = 0, nxcc_act = 0;
    for (int st = 0; st < 26; ++st) {
        const int l = st < 2 ? 0 : (st - 2) / 12;
        const int ph = st < 2 ? st : 2 + (st - 2) % 12;
        PP p = (PP)__builtin_amdgcn_kernarg_segment_ptr();
        asm volatile("" : "+s"(p));
        const int G = GDIM(), bid = BID();
        unsigned char* ws = p->ws;
        float* mod = (float*)(ws + O_MOD);
        bf16_t* hbuf = (bf16_t*)(ws + O_D);
        float* vbuf = (float*)(ws + O_B);
        const float* ml = mod + l * 12288;
        switch (ph) {
        case 0:
            phase_mod(lds, p); phase_weights(lds, p, 0); phase_s5pre(lds, p, 0);
            break;
        case 1:
            phase_ln<false, true>(p->in[0], nullptr, nullptr, nullptr, mod + 0, mod + 2048, hbuf);
            break;
        case 2: {
            Gemm g{hbuf, (const bf16_t*)(ws + O_WIN), DM, DM, DM}; StaticOrder S; S.init(L, NPROJ, G, bid);
            EpiProj E{(bf16_t*)(ws + O_E), (bf16_t*)(ws + O_QKV), (bf16_t*)(ws + O_Z), (bf16_t*)(ws + O_SGS), (bf16_t*)(ws + O_SGG), (float*)(ws + O_LOG)};
            gemm_phase(lds, g, S, E); } break;
        case 3: {
            Gemm g{(const bf16_t*)(ws + O_E), (const bf16_t*)(ws + O_M2), 640, 512, 512}; OrderS5X S{G, bid}; EpiXend E{(float*)(ws + O_XEND)};
            gemm_phase(lds, g, S, E); } break;
        case 4:
            if (bid < 8) phase_carry(p, bid);
            else { for (int item = bid - 8; item < 2048; item += G - 8) gdn_intra(lds, p, l, item); }
            break;
        case 5:
            if (bid < 16) gdn_scan(lds, p, bid);
            else { Gemm g{(const bf16_t*)(ws + O_E), (const bf16_t*)(ws + O_BT2), 640, 640, 640}; OrderS5Y S{G - 16, bid - 16};
                   EpiS5Y E{(const bf16_t*)(ws + O_E), p->in[12] + l * 1024, (bf16_t*)(ws + O_ZS)}; gemm_phase(lds, g, S, E); }
            break;
        case 6: {
            phase_normgate(p, l, G, bid);
            Gemm g{(const bf16_t*)(ws + O_ZS), (const bf16_t*)(ws + O_WGLU), 1024, 1024, 1024}; StaticOrder S; S.init(L, 1024, G, bid);
            EpiGlu E{(const bf16_t*)(ws + O_ZS), p->in[14] + l * 1024, (bf16_t*)(ws + O_Y2)}; gemm_phase(lds, g, S, E); } break;
        case 7: {
            Gemm g{(const bf16_t*)(ws + O_Y2), (const bf16_t*)(ws + O_WUPS), 1024, 1024, 1024}; StaticOrder S; S.init(L, 2048, G, bid);
            EpiUp<0> E{(const bf16_t*)(ws + O_SGS), nullptr, (bf16_t*)(ws + O_T1)}; gemm_phase(lds, g, S, E); } break;
        case 8: {
            Gemm g{(const bf16_t*)(ws + O_OBF), (const bf16_t*)(ws + O_WUPG), 1024, 1024, 1024}; StaticOrder S; S.init(L, 2048, G, bid);
            EpiUp<1> E{(const bf16_t*)(ws + O_SGG), (const bf16_t*)(ws + O_T1), (bf16_t*)(ws + O_MRG)}; gemm_phase(lds, g, S, E); } break;
        case 9: {
            const float* xin = l == 0 ? p->in[0] : p->out;
            Gemm g{(const bf16_t*)(ws + O_MRG), (const bf16_t*)(ws + O_WOUT), DM, DM, DM}; StaticOrder S; S.init(L, DM, G, bid);
            EpiResid E{xin, ml + 4096, vbuf}; gemm_phase(lds, g, S, E); } break;
        case 10:
            phase_ln<true, true>(vbuf, p->in[22] + l * DM, p->in[23] + l * DM, vbuf, ml + 6144, ml + 8192, hbuf);
            break;
        case 11: {
            Gemm g{hbuf, (const bf16_t*)(ws + O_WF1), DM, DM, DM}; StaticOrder S; S.init(L, 2 * FH, G, bid);
            EpiSwiglu E{(bf16_t*)(ws + O_A)}; gemm_phase(lds, g, S, E); } break;
        case 12: {
            Gemm g{(const bf16_t*)(ws + O_A), (const bf16_t*)(ws + O_WF2), FH, FH, FH}; StaticOrder S; S.init(L, DM, G, bid);
            EpiResid E{vbuf, ml + 10240, vbuf}; gemm_phase(lds, g, S, E); } break;
        default:
            if (l == 0) {
                phase_ln<true, true>(vbuf, p->in[26], p->in[27], p->out, mod + 12288, mod + 12288 + 2048, hbuf);
                __syncthreads();
                phase_weights(lds, p, 1);
                phase_s5pre(lds, p, 1);
            } else {
                phase_ln<true, false>(vbuf, p->in[26] + DM, p->in[27] + DM, p->out, nullptr, nullptr, nullptr);
            }
            break;
        }
        if (st == 0) {
            grid.sync();
            unsigned* bar = (unsigned*)(ws + O_BAR);
            for (int x = 0; x < 8; ++x) { const unsigned c = __hip_atomic_load(bar + 512 + 64 * x, __ATOMIC_RELAXED, __HIP_MEMORY_SCOPE_AGENT); nxcc_act += c ? 1u : 0u; if (x == (int)my_xcc) nx_mine = c; }
        } else if (st != 25) gbar((unsigned*)(ws + O_BAR), (unsigned)st, nx_mine, nxcc_act, my_xcc);
    }
}

extern "C" void kernel_launch(void* const* d_in, const int* in_sizes, int n_in, void* d_out, int out_size, void* d_ws, size_t ws_size, hipStream_t stream) {
    static int grid_blocks = 0;
    if (grid_blocks == 0) {
        if (n_in != 28 || ws_size < WS_END) { fprintf(stderr, "kernel_launch: need 28 inputs and %zu bytes of workspace; got %d, %zu\n", (size_t)WS_END, n_in, ws_size); grid_blocks = -1; return; }
        int dev = 0, cus = 0, per_cu = 0;
        hipGetDevice(&dev);
        hipDeviceGetAttribute(&cus, hipDeviceAttributeMultiprocessorCount, dev);
        if (hipFuncSetAttribute((const void*)hybrid_fwd, hipFuncAttributeMaxDynamicSharedMemorySize, LDS_BYTES) != hipSuccess) { fprintf(stderr, "kernel_launch: hipFuncSetAttribute failed\n"); grid_blocks = -1; return; }
        hipOccupancyMaxActiveBlocksPerMultiprocessor(&per_cu, (const void*)hybrid_fwd, NTHR, LDS_BYTES);
        if (per_cu < 1) { fprintf(stderr, "kernel_launch: occupancy query says %d blocks per CU\n", per_cu); per_cu = 1; }
        (void)hipGetLastError();
        grid_blocks = cus;
    }
    if (grid_blocks < 0) return;
    Params p{};
    for (int i = 0; i < 28; ++i) p.in[i] = (const float*)d_in[i];
    p.out = (float*)d_out; p.ws = (unsigned char*)d_ws;
    if (hipMemsetAsync((char*)d_ws + O_BAR, 0, 8192, stream) != hipSuccess) { fprintf(stderr, "kernel_launch: hipMemsetAsync failed\n"); return; }
    void* args[] = {&p};
    hipError_t e = hipLaunchCooperativeKernel((const void*)hybrid_fwd, dim3(grid_blocks), dim3(NTHR), args, LDS_BYTES, stream);
    if (e != hipSuccess) fprintf(stderr, "cooperative launch failed: %s (grid %d)\n", hipGetErrorString(e), grid_blocks);
}
```

```cpp
#include <hip/hip_runtime.h>
#include <hip/hip_cooperative_groups.h>
#include <cstdio>
namespace cg = cooperative_groups;

#define LAS __attribute__((address_space(3)))
#define DI __device__ __forceinline__
typedef unsigned short bf16_t;
typedef short bf16x8 __attribute__((ext_vector_type(8)));
typedef float f32x2 __attribute__((ext_vector_type(2)));
typedef float f32x4 __attribute__((ext_vector_type(4)));
typedef float f32x16 __attribute__((ext_vector_type(16)));
typedef unsigned u32x4 __attribute__((ext_vector_type(4)));
typedef unsigned u32x2 __attribute__((ext_vector_type(2)));
typedef __bf16 bf2_t __attribute__((ext_vector_type(2)));

constexpr int L = 16384, DM = 2048, NPROJ = 9472, FH = 5632, NTHR = 512;
constexpr float ALPHA = 1.41421356237f;
constexpr int LDS_BYTES = 143360;

constexpr size_t SZ_WIN = (size_t)NPROJ * DM * 2, SZ_WGLU = 1024ull * 1024 * 2, SZ_WUP = 2048ull * 1024 * 2, SZ_WOUT = 2048ull * 2048 * 2,
                 SZ_WF1 = 11264ull * 2048 * 2, SZ_WF2 = 2048ull * 5632 * 2;
constexpr size_t O_WIN = 0, O_WGLU = O_WIN + SZ_WIN, O_WUPS = O_WGLU + SZ_WGLU, O_WUPG = O_WUPS + SZ_WUP, O_WOUT = O_WUPG + SZ_WUP,
                 O_WF1 = O_WOUT + SZ_WOUT, O_WF2 = O_WF1 + SZ_WF1;
constexpr size_t SZ_BT2 = 64ull * 512 * 640 * 2, SZ_M2 = 64ull * 256 * 512 * 2;
constexpr size_t O_BT2 = O_WF2 + SZ_WF2, O_M2 = O_BT2 + SZ_BT2;
constexpr size_t SZ_A = (size_t)L * FH * 2;
constexpr size_t O_A = O_M2 + SZ_M2;
constexpr size_t FRAG_ITEM = 57344, UFR_ITEM = 32768;
constexpr size_t O_UFR = O_A + 2048 * FRAG_ITEM;
constexpr size_t O_MRG = O_A;
constexpr size_t SZ_B = (size_t)L * DM * 4;
constexpr size_t O_B = O_A + SZ_A, O_QKV = O_B, O_Z = O_B + (size_t)L * 3072 * 2;
constexpr size_t O_Y2 = O_QKV, O_T1 = O_QKV + (size_t)L * 1024 * 2;
constexpr size_t O_C = O_B + SZ_B, O_SGS = O_C, O_SGG = O_C + (size_t)L * 2048 * 2;
constexpr size_t O_D = O_C + 2 * (size_t)L * 2048 * 2;
constexpr size_t O_ZS = O_D, O_OBF = O_D + (size_t)L * 1024 * 2;
constexpr size_t O_E = O_D + (size_t)L * 2048 * 2;
constexpr size_t O_LOG = O_E + 64ull * 512 * 640 * 2;
constexpr size_t O_XEND = O_LOG + (size_t)L * 16 * 4;
constexpr size_t O_MOD = O_XEND + 64ull * 512 * 128 * 4;
constexpr size_t O_A32 = O_MOD + 2 * 12288 * 4;
constexpr size_t O_GL = O_A32 + 64 * 64 * 2 * 4;
constexpr size_t O_BAR = O_GL + 8 * 256 * 4;
constexpr size_t O_LOG2 = O_BAR + 8192;
constexpr size_t WS_END = O_LOG2 + (size_t)L * 16 * 4;

struct Params {
    const float* in[28];
    float* out;
    unsigned char* ws;
};

extern "C" __device__ size_t __ockl_get_num_groups(unsigned);
typedef const __attribute__((address_space(4))) Params* PP;
DI int TID() { int t = __builtin_amdgcn_workitem_id_x(); asm volatile("" : "+v"(t)); return t; }
DI int GDIM() { return (int)__ockl_get_num_groups(0); }
DI int BID() { int t = __builtin_amdgcn_workgroup_id_x(); asm volatile("" : "+s"(t)); return t; }
DI unsigned pk2(float lo, float hi) { f32x2 v = {lo, hi}; bf2_t b = __builtin_convertvector(v, bf2_t); return __builtin_bit_cast(unsigned, b); }
DI bf16_t f2bf(float f) { return (bf16_t)(pk2(f, 0.f) & 0xffffu); }
DI float bflo(unsigned w) { return __uint_as_float(w << 16); }
DI float bfhi(unsigned w) { return __uint_as_float(w & 0xffff0000u); }
DI void unpack8(u32x4 w, float* f) { f[0] = bflo(w.x); f[1] = bfhi(w.x); f[2] = bflo(w.y); f[3] = bfhi(w.y); f[4] = bflo(w.z); f[5] = bfhi(w.z); f[6] = bflo(w.w); f[7] = bfhi(w.w); }
DI u32x4 pack8(const float* f) { u32x4 w; w.x = pk2(f[0], f[1]); w.y = pk2(f[2], f[3]); w.z = pk2(f[4], f[5]); w.w = pk2(f[6], f[7]); return w; }
DI u32x4 pack44(f32x4 a, f32x4 b) { u32x4 w; w.x = pk2(a[0], a[1]); w.y = pk2(a[2], a[3]); w.z = pk2(b[0], b[1]); w.w = pk2(b[2], b[3]); return w; }
DI float sigmoidf_(float x) { return 1.f / (1.f + __expf(-x)); }
DI float siluf_(float x) { return x / (1.f + __expf(-x)); }
DI float gelu_tanh(float y) { float t = 0.7978845608f * (y + 0.044715f * y * y * y); float e = __expf(2.f * t); return 0.5f * y * (2.f - 2.f / (e + 1.f)); }
DI void lds_barrier() { asm volatile("s_waitcnt lgkmcnt(0)" ::: "memory"); __builtin_amdgcn_s_barrier(); asm volatile("" ::: "memory"); }
DI unsigned xcc_id() { return (unsigned)__builtin_amdgcn_s_getreg((3 << 11) | 20) & 7u; }
DI void gbar(unsigned* bar, unsigned k, unsigned nx, unsigned nxcc, unsigned xcc) {
    asm volatile("s_waitcnt vmcnt(0) lgkmcnt(0)" ::: "memory");
    __builtin_amdgcn_s_barrier();
    if (__builtin_amdgcn_workitem_id_x() == 0) {
        const unsigned old = __hip_atomic_fetch_add(bar + 64 * xcc, 1u, __ATOMIC_RELAXED, __HIP_MEMORY_SCOPE_AGENT);
        if (old + 1u == k * nx) {
            __builtin_amdgcn_fence(__ATOMIC_RELEASE, "agent");
            asm volatile("s_waitcnt vmcnt(0) lgkmcnt(0)" ::: "memory");
            __hip_atomic_fetch_add(bar + 1024, 1u, __ATOMIC_RELAXED, __HIP_MEMORY_SCOPE_AGENT);
            while (__hip_atomic_load(bar + 1024, __ATOMIC_RELAXED, __HIP_MEMORY_SCOPE_AGENT) < k * nxcc) __builtin_amdgcn_s_sleep(1);
            __hip_atomic_store(bar + 1536 + 64 * xcc, k, __ATOMIC_RELAXED, __HIP_MEMORY_SCOPE_AGENT);
        } else {
            while (__hip_atomic_load(bar + 1536 + 64 * xcc, __ATOMIC_RELAXED, __HIP_MEMORY_SCOPE_AGENT) < k) __builtin_amdgcn_s_sleep(1);
        }
        __builtin_amdgcn_fence(__ATOMIC_ACQUIRE, "agent");
        asm volatile("s_waitcnt vmcnt(0)" ::: "memory");
    }
    asm volatile("" ::: "memory");
    __builtin_amdgcn_s_barrier();
    asm volatile("" ::: "memory");
}
DI void subbar(unsigned* cnt, unsigned target) {
    asm volatile("s_waitcnt vmcnt(0) lgkmcnt(0)" ::: "memory");
    __builtin_amdgcn_s_barrier();
    if (__builtin_amdgcn_workitem_id_x() == 0) {
        __builtin_amdgcn_fence(__ATOMIC_RELEASE, "agent");
        asm volatile("s_waitcnt vmcnt(0) lgkmcnt(0)" ::: "memory");
        __hip_atomic_fetch_add(cnt, 1u, __ATOMIC_RELAXED, __HIP_MEMORY_SCOPE_AGENT);
        while (__hip_atomic_load(cnt, __ATOMIC_RELAXED, __HIP_MEMORY_SCOPE_AGENT) < target) __builtin_amdgcn_s_sleep(4);
        __builtin_amdgcn_fence(__ATOMIC_ACQUIRE, "agent");
        asm volatile("s_waitcnt vmcnt(0)" ::: "memory");
    }
    asm volatile("" ::: "memory");
    __builtin_amdgcn_s_barrier();
    asm volatile("" ::: "memory");
}
DI int crow(int reg, int h) { return (reg & 3) + 8 * (reg >> 2) + 4 * h; }
#define MFMA32(a, b, c) __builtin_amdgcn_mfma_f32_32x32x16_bf16((a), (b), (c), 0, 0, 0)

namespace pg8 {
constexpr int BM = 256, BK = 64, HALF = 128, HTB = HALF * BK * 2, STAGE_BYTES = 8 * HTB, NXCD = 8, WGM = 8;
DI int lds_byte(int r, int c) { const int st = (r >> 4) * 2 + (c >> 5), rr = r & 15, cc = c & 31, ob = rr * 64 + cc * 2; return st * 1024 + (ob ^ (((ob >> 9) & 1) << 5)); }
DI void stage_rc(int b, int& R, int& C) { const int st = b / 1024, sb = b % 1024, swz = sb ^ (((sb >> 9) & 1) << 5); R = (st >> 1) * 16 + swz / 64; C = (st & 1) * 32 + (swz % 64) / 2; }
DI int perm32(int rho) { const int n = rho >> 4, i = rho & 15; return 8 * (i >> 2) + 4 * n + (i & 3); }
struct Unit { int pm, pn; };
struct Gemm { const bf16_t* A; const bf16_t* Bt; int lda, ldb, K; };

struct StaticOrder {
    int nM, nN, nwg, G, c;
    DI void init(int M, int N, int G_, int c_) { nM = M / BM; nN = N / BM; nwg = nM * nN; G = G_; c = c_; }
    DI bool next(int i, Unit& u) const {
        const long Li = (long)i * G + c; if (c < 0 || Li >= nwg) return false;
        int wgid = (int)Li; { const int q = nwg / NXCD, r = nwg % NXCD, xcd = wgid % NXCD, off = wgid / NXCD; wgid = (xcd < r ? xcd * (q + 1) : r * (q + 1) + (xcd - r) * q) + off; }
        const int nig = WGM * nN, gid = wgid / nig, fm = gid * WGM, gsz = (nM - fm) < WGM ? (nM - fm) : WGM;
        u.pm = fm + ((wgid % nig) % gsz); u.pn = (wgid % nig) / gsz; return true;
    }
};
struct OrderS5Y { int G, c; DI bool next(int i, Unit& u) const { const int Li = i * G + c; if (c < 0 || Li >= 256) return false; const int g = Li >> 2; u.pm = 2 * g + ((Li >> 1) & 1); u.pn = 2 * g + (Li & 1); return true; } };
struct OrderProj : StaticOrder { int logit; DI bool next(int i, Unit& u) const { if (!logit) return StaticOrder::next(i, u); if (i != 0 || c < 0 || c >= 64) return false; u.pm = c; u.pn = 36; return true; } };
struct OrderS5X { int G, c; DI bool next(int i, Unit& u) const { const int Li = i * G + c; if (c < 0 || Li >= 128) return false; const int g = Li >> 1; u.pm = 2 * g + (Li & 1); u.pn = g; return true; } };

template <class Epi, class Sched>
DI void gemm_phase(LAS unsigned char* lds, const Gemm g, const Sched& S, const Epi& E) {
    const int tid = TID(), wid = __builtin_amdgcn_readfirstlane(tid >> 6), lane = tid & 63, wr = wid >> 2, wc = wid & 3, fr = lane & 15, fq = lane >> 4;
    const int K = g.K, nt = K / BK;
    unsigned voffA[2], voffB[2];
#pragma unroll
    for (int i = 0; i < 2; ++i) { int R, C; stage_rc(tid * 16 + i * 8192, R, C); const int Rb = Epi::PERM ? ((R & ~31) + perm32(R & 31)) : R;
        voffA[i] = (unsigned)(R * g.lda + C) * 2u; voffB[i] = (unsigned)(Rb * g.ldb + C) * 2u; }
    const size_t kstep = (size_t)(BK * 2);
    const size_t hstepA = (size_t)HALF * g.lda * 2, hstepB = (size_t)HALF * g.ldb * 2;
    const size_t tstepA = 2 * hstepA, tstepB = 2 * hstepB;
    const unsigned ldsw = (unsigned)wid * 1024u;
    const int aoff = lds_byte(wr * 64 + fr, fq * 8), boff = lds_byte(wc * 32 + fr, fq * 8);
#define PG8_SA(b, h) (((b) * 2 + (h)) * HTB)
#define PG8_SB(b, h) ((4 + (b) * 2 + (h)) * HTB)
#define PG8_STAGE(bufoff, gbase, voff) do { _Pragma("unroll") for (int _i = 0; _i < 2; ++_i) \
        __builtin_amdgcn_global_load_lds((const unsigned*)((const char*)(gbase) + (voff)[_i]), (LAS unsigned*)(lds + (bufoff) + ldsw + _i * 8192), 16, 0, 0); } while (0)
#define PG8_LDA(dst, b, h) do { _Pragma("unroll") for (int m = 0; m < 4; ++m) _Pragma("unroll") for (int k = 0; k < 2; ++k) dst[m][k] = *(const LAS bf16x8*)(lds + PG8_SA(b, h) + aoff + m * 2048 + k * 1024); } while (0)
#define PG8_LDB(dst, b, h) do { _Pragma("unroll") for (int n = 0; n < 2; ++n) _Pragma("unroll") for (int k = 0; k < 2; ++k) dst[n][k] = *(const LAS bf16x8*)(lds + PG8_SB(b, h) + boff + n * 2048 + k * 1024); } while (0)
#define PG8_MMA(ai, bj, At, Bt) do { __builtin_amdgcn_s_setprio(1); _Pragma("unroll") for (int m = 0; m < 4; ++m) _Pragma("unroll") for (int n = 0; n < 2; ++n) _Pragma("unroll") for (int k = 0; k < 2; ++k) \
        acc[ai][bj][m][n] = __builtin_amdgcn_mfma_f32_16x16x32_bf16(Bt[n][k], At[m][k], acc[ai][bj][m][n], 0, 0, 0); __builtin_amdgcn_s_setprio(0); } while (0)
#define PG8_WAIT_V(n) asm volatile("s_waitcnt vmcnt(" #n ")" ::: "memory")
#define PG8_WAIT_L(n) asm volatile("s_waitcnt lgkmcnt(" #n ")" ::: "memory")
#define PG8_BAR __builtin_amdgcn_s_barrier()
#define PG8_SCHED __builtin_amdgcn_sched_barrier(0)
    Unit cur, nxt; int ui = 0;
    if (!S.next(0, cur)) return;
    f32x4 acc[2][2][4][2];
#pragma unroll
    for (int a = 0; a < 2; ++a)
#pragma unroll
        for (int b = 0; b < 2; ++b)
#pragma unroll
            for (int m = 0; m < 4; ++m)
#pragma unroll
                for (int n = 0; n < 2; ++n) acc[a][b][m][n] = (f32x4){0.f, 0.f, 0.f, 0.f};
    bf16x8 At[4][2], B0[2][2], B1[2][2];
    const char* cA = (const char*)g.A + (size_t)cur.pm * tstepA; const char* cB = (const char*)g.Bt + (size_t)cur.pn * tstepB;
    PG8_STAGE(PG8_SB(0, 0), cB, voffB); PG8_STAGE(PG8_SA(0, 0), cA, voffA); PG8_STAGE(PG8_SB(0, 1), cB + hstepB, voffB); PG8_STAGE(PG8_SA(0, 1), cA + hstepA, voffA);
    if (wr == 1) PG8_BAR;
    PG8_WAIT_V(4); PG8_BAR;
    PG8_STAGE(PG8_SB(1, 0), cB + kstep, voffB); PG8_STAGE(PG8_SA(1, 0), cA + kstep, voffA); PG8_STAGE(PG8_SB(1, 1), cB + hstepB + kstep, voffB);
    PG8_WAIT_V(6); PG8_BAR;
    for (;;) {
        const bool has_next = S.next(ui + 1, nxt);
        const char* nA = has_next ? (const char*)g.A + (size_t)nxt.pm * tstepA : cA; const char* nB = has_next ? (const char*)g.Bt + (size_t)nxt.pn * tstepB : cB;
        for (int t = 0; t < nt; t += 2) {
            const bool last = (t == nt - 2);
            const char* a1 = cA + (size_t)(t + 1) * kstep;
            const char* a2 = last ? nA : cA + (size_t)(t + 2) * kstep; const char* b2 = last ? nB : cB + (size_t)(t + 2) * kstep;
            const char* a3 = a2 + kstep; const char* b3 = b2 + kstep;
            PG8_LDB(B0, 0, 0); PG8_SCHED; PG8_LDA(At, 0, 0); PG8_STAGE(PG8_SA(1, 1), a1 + hstepA, voffA);
            PG8_WAIT_L(8); PG8_BAR; PG8_WAIT_L(0); PG8_MMA(0, 0, At, B0); PG8_BAR; PG8_SCHED;
            PG8_LDB(B1, 0, 1); PG8_STAGE(PG8_SB(0, 0), b2, voffB);
            PG8_BAR; PG8_WAIT_L(0); PG8_MMA(0, 1, At, B1); PG8_BAR;
            PG8_LDA(At, 0, 1); PG8_STAGE(PG8_SA(0, 0), a2, voffA);
            PG8_BAR; PG8_WAIT_L(0); PG8_MMA(1, 0, At, B0); PG8_BAR; PG8_SCHED;
            PG8_STAGE(PG8_SB(0, 1), b2 + hstepB, voffB);
            PG8_WAIT_V(6); PG8_BAR; PG8_MMA(1, 1, At, B1); PG8_BAR;
            PG8_LDB(B0, 1, 0); PG8_SCHED; PG8_LDA(At, 1, 0); PG8_STAGE(PG8_SA(0, 1), a2 + hstepA, voffA);
            PG8_WAIT_L(8); PG8_BAR; PG8_WAIT_L(0); PG8_MMA(0, 0, At, B0); PG8_BAR; PG8_SCHED;
            PG8_LDB(B1, 1, 1); PG8_STAGE(PG8_SB(1, 0), b3, voffB);
            PG8_BAR; PG8_WAIT_L(0); PG8_MMA(0, 1, At, B1); PG8_BAR;
            PG8_LDA(At, 1, 1); PG8_STAGE(PG8_SA(1, 0), a3, voffA);
            PG8_BAR; PG8_WAIT_L(0); PG8_MMA(1, 0, At, B0); PG8_BAR; PG8_SCHED;
            PG8_STAGE(PG8_SB(1, 1), b3 + hstepB, voffB);
            PG8_WAIT_V(6); PG8_BAR; PG8_MMA(1, 1, At, B1); PG8_BAR;
        }
        E(acc, cur, wr, wc, fr, fq);
        if (!has_next) break;
#pragma unroll
        for (int a = 0; a < 2; ++a)
#pragma unroll
            for (int b = 0; b < 2; ++b)
#pragma unroll
                for (int m = 0; m < 4; ++m)
#pragma unroll
                    for (int n = 0; n < 2; ++n) acc[a][b][m][n] = (f32x4){0.f, 0.f, 0.f, 0.f};
        cur = nxt; cA = nA; cB = nB; ++ui;
    }
    PG8_WAIT_V(0);
    if (wr == 0) PG8_BAR;
    PG8_BAR;
#undef PG8_SA
#undef PG8_SB
#undef PG8_STAGE
#undef PG8_LDA
#undef PG8_LDB
#undef PG8_MMA
#undef PG8_WAIT_V
#undef PG8_WAIT_L
#undef PG8_BAR
#undef PG8_SCHED
}

typedef f32x4 Acc[2][2][4][2];
#define EPI_LOOP_PERM(...) _Pragma("unroll") for (int ai = 0; ai < 2; ++ai) _Pragma("unroll") for (int m = 0; m < 4; ++m) { const int row = u.pm * 256 + ai * 128 + wr * 64 + m * 16 + fr; \
    _Pragma("unroll") for (int bj = 0; bj < 2; ++bj) { const int c8 = bj * 128 + wc * 32 + 8 * fq; f32x4 v0 = acc[ai][bj][m][0], v1 = acc[ai][bj][m][1]; __VA_ARGS__ } }

struct EpiProj {
    static constexpr bool PERM = true;
    bf16_t *uperm, *qkv, *z, *sgs, *sgg; float* logit;
    DI void operator()(const Acc& acc, const Unit& u, int wr, int wc, int fr, int fq) const {
        const int pn = u.pn;
        if (pn < 4) {
            EPI_LOOP_PERM({ const int ch = pn * 256 + c8; *(u32x4*)(uperm + ((size_t)((ch >> 4) * 512 + (row >> 5)) * 640 + (row & 31) * 16 + (ch & 15))) = pack44(v0, v1); })
        } else if (pn < 16) {
            EPI_LOOP_PERM({ *(u32x4*)(qkv + (size_t)row * 3072 + (pn - 4) * 256 + c8) = pack44(v0, v1); })
        } else if (pn < 20) {
            EPI_LOOP_PERM({ *(u32x4*)(z + (size_t)row * 1024 + (pn - 16) * 256 + c8) = pack44(v0, v1); })
        } else if (pn < 36) {
            bf16_t* dst = pn < 28 ? sgs + (pn - 20) * 256 : sgg + (pn - 28) * 256;
            EPI_LOOP_PERM({ for (int j = 0; j < 4; ++j) { v0[j] = sigmoidf_(v0[j]); v1[j] = sigmoidf_(v1[j]); } *(u32x4*)(dst + (size_t)row * 2048 + c8) = pack44(v0, v1); })
        } else {
            EPI_LOOP_PERM({ if (bj == 0 && wc == 0 && fq < 2) { *(f32x4*)(logit + (size_t)row * 16 + 8 * fq) = v0; *(f32x4*)(logit + (size_t)row * 16 + 8 * fq + 4) = v1; } })
        }
    }
};
struct EpiXend {
    static constexpr bool PERM = false;
    float* xend;
    DI void operator()(const Acc& acc, const Unit& u, int wr, int wc, int fr, int fq) const {
#pragma unroll
        for (int ai = 0; ai < 2; ++ai)
#pragma unroll
            for (int m = 0; m < 4; ++m) { const int row = u.pm * 256 + ai * 128 + wr * 64 + m * 16 + fr;
#pragma unroll
                for (int n = 0; n < 2; ++n) *(f32x4*)(xend + (size_t)row * 128 + wc * 32 + 16 * n + 4 * fq) = acc[ai][0][m][n]; }
    }
};
struct EpiS5Y {
    static constexpr bool PERM = true;
    const bf16_t* uperm; const float* dskip; bf16_t* zs;
    DI void operator()(const Acc& acc, const Unit& u, int wr, int wc, int fr, int fq) const {
        const int g = u.pm >> 1, mt = u.pm & 1, nt = u.pn & 1, ho0 = 8 * (fq & 1);
        const f32x4 d0 = *(const f32x4*)(dskip + g * 16 + ho0), d1 = *(const f32x4*)(dskip + g * 16 + ho0 + 4);
#pragma unroll
        for (int ai = 0; ai < 2; ++ai)
#pragma unroll
            for (int mp = 0; mp < 2; ++mp) {
                u32x4 uv[2][2];
#pragma unroll
                for (int mi = 0; mi < 2; ++mi)
#pragma unroll
                    for (int bj = 0; bj < 2; ++bj) { const int chunk = mt * 256 + ai * 128 + wr * 64 + (2 * mp + mi) * 16 + fr, n0 = nt * 256 + bj * 128 + wc * 32 + 8 * fq;
                        uv[mi][bj] = *(const u32x4*)(uperm + (size_t)(g * 512 + chunk) * 640 + n0); }
#pragma unroll
                for (int mi = 0; mi < 2; ++mi)
#pragma unroll
                    for (int bj = 0; bj < 2; ++bj) { const int m = 2 * mp + mi, chunk = mt * 256 + ai * 128 + wr * 64 + m * 16 + fr, n0 = nt * 256 + bj * 128 + wc * 32 + 8 * fq, t = n0 >> 4;
                        f32x4 v0 = acc[ai][bj][m][0], v1 = acc[ai][bj][m][1]; float uf[8]; unpack8(uv[mi][bj], uf);
                        for (int j = 0; j < 4; ++j) { v0[j] = gelu_tanh(v0[j] + d0[j] * uf[j]); v1[j] = gelu_tanh(v1[j] + d1[j] * uf[4 + j]); }
                        *(u32x4*)(zs + (size_t)(chunk * 32 + t) * 1024 + g * 16 + ho0) = pack44(v0, v1); }
            }
    }
};
struct EpiGlu {
    static constexpr bool PERM = true;
    const bf16_t* zs; const float* bias; bf16_t* y2;
    DI void operator()(const Acc& acc, const Unit& u, int wr, int wc, int fr, int fq) const {
        f32x4 bv[2][2];
#pragma unroll
        for (int bj = 0; bj < 2; ++bj) { const int col = u.pn * 256 + bj * 128 + wc * 32 + 8 * fq; bv[bj][0] = *(const f32x4*)(bias + col); bv[bj][1] = *(const f32x4*)(bias + col + 4); }
#pragma unroll
        for (int ai = 0; ai < 2; ++ai)
#pragma unroll
            for (int mp = 0; mp < 2; ++mp) {
                u32x4 zv[2][2];
#pragma unroll
                for (int mi = 0; mi < 2; ++mi)
#pragma unroll
                    for (int bj = 0; bj < 2; ++bj) { const int row = u.pm * 256 + ai * 128 + wr * 64 + (2 * mp + mi) * 16 + fr, col = u.pn * 256 + bj * 128 + wc * 32 + 8 * fq;
                        zv[mi][bj] = *(const u32x4*)(zs + (size_t)row * 1024 + col); }
#pragma unroll
                for (int mi = 0; mi < 2; ++mi)
#pragma unroll
                    for (int bj = 0; bj < 2; ++bj) { const int m = 2 * mp + mi, row = u.pm * 256 + ai * 128 + wr * 64 + m * 16 + fr, col = u.pn * 256 + bj * 128 + wc * 32 + 8 * fq;
                        f32x4 v0 = acc[ai][bj][m][0], v1 = acc[ai][bj][m][1]; float zf[8]; unpack8(zv[mi][bj], zf);
                        for (int j = 0; j < 4; ++j) { v0[j] = zf[j] * sigmoidf_(v0[j] + bv[bj][0][j]); v1[j] = zf[4 + j] * sigmoidf_(v1[j] + bv[bj][1][j]); }
                        *(u32x4*)(y2 + (size_t)row * 1024 + col) = pack44(v0, v1); }
            }
    }
};
template <int SECOND> struct EpiUp {
    static constexpr bool PERM = true;
    const bf16_t* gate; const bf16_t* t1in; bf16_t* dst;
    DI void operator()(const Acc& acc, const Unit& u, int wr, int wc, int fr, int fq) const {
#pragma unroll
        for (int ai = 0; ai < 2; ++ai)
#pragma unroll
            for (int mp = 0; mp < 2; ++mp) {
                u32x4 gv[2][2], tv[2][2];
#pragma unroll
                for (int mi = 0; mi < 2; ++mi)
#pragma unroll
                    for (int bj = 0; bj < 2; ++bj) { const size_t o = (size_t)(u.pm * 256 + ai * 128 + wr * 64 + (2 * mp + mi) * 16 + fr) * 2048 + u.pn * 256 + bj * 128 + wc * 32 + 8 * fq;
                        gv[mi][bj] = *(const u32x4*)(gate + o); if (SECOND) tv[mi][bj] = *(const u32x4*)(t1in + o); else tv[mi][bj] = (u32x4){0u, 0u, 0u, 0u}; }
#pragma unroll
                for (int mi = 0; mi < 2; ++mi)
#pragma unroll
                    for (int bj = 0; bj < 2; ++bj) { const int m = 2 * mp + mi; const size_t o = (size_t)(u.pm * 256 + ai * 128 + wr * 64 + m * 16 + fr) * 2048 + u.pn * 256 + bj * 128 + wc * 32 + 8 * fq;
                        f32x4 v0 = acc[ai][bj][m][0], v1 = acc[ai][bj][m][1]; float gf[8], tf[8]; unpack8(gv[mi][bj], gf); unpack8(tv[mi][bj], tf);
                        for (int j = 0; j < 4; ++j) { v0[j] = tf[j] + gf[j] * v0[j]; v1[j] = tf[4 + j] + gf[4 + j] * v1[j]; }
                        *(u32x4*)(dst + o) = pack44(v0, v1); }
            }
    }
};
struct EpiBranch {
    static constexpr bool PERM = true;
    const float* gate; bf16_t* y;
    DI void operator()(const Acc& acc, const Unit& u, int wr, int wc, int fr, int fq) const {
        f32x4 gv[2][2];
#pragma unroll
        for (int bj = 0; bj < 2; ++bj) { const int col = u.pn * 256 + bj * 128 + wc * 32 + 8 * fq; gv[bj][0] = *(const f32x4*)(gate + col); gv[bj][1] = *(const f32x4*)(gate + col + 4); }
        EPI_LOOP_PERM({ *(u32x4*)(y + (size_t)row * 2048 + u.pn * 256 + c8) = pack44(gv[bj][0] * v0, gv[bj][1] * v1); })
    }
};
struct EpiResid {
    static constexpr bool PERM = false;
    const float* xin; const float* gate; float* out;
    DI void operator()(const Acc& acc, const Unit& u, int wr, int wc, int fr, int fq) const {
        f32x4 gv[2][2];
#pragma unroll
        for (int bj = 0; bj < 2; ++bj)
#pragma unroll
            for (int n = 0; n < 2; ++n) gv[bj][n] = *(const f32x4*)(gate + u.pn * 256 + bj * 128 + wc * 32 + 16 * n + 4 * fq);
#pragma unroll
        for (int ai = 0; ai < 2; ++ai)
#pragma unroll
            for (int mp = 0; mp < 2; ++mp) {
                f32x4 xv[2][2][2];
#pragma unroll
                for (int mi = 0; mi < 2; ++mi)
#pragma unroll
                    for (int bj = 0; bj < 2; ++bj)
#pragma unroll
                        for (int n = 0; n < 2; ++n) xv[mi][bj][n] = *(const f32x4*)(xin + (size_t)(u.pm * 256 + ai * 128 + wr * 64 + (2 * mp + mi) * 16 + fr) * 2048 + u.pn * 256 + bj * 128 + wc * 32 + 16 * n + 4 * fq);
#pragma unroll
                for (int mi = 0; mi < 2; ++mi)
#pragma unroll
                    for (int bj = 0; bj < 2; ++bj)
#pragma unroll
                        for (int n = 0; n < 2; ++n) { const int m = 2 * mp + mi;
                            *(f32x4*)(out + (size_t)(u.pm * 256 + ai * 128 + wr * 64 + m * 16 + fr) * 2048 + u.pn * 256 + bj * 128 + wc * 32 + 16 * n + 4 * fq) = ALPHA * xv[mi][bj][n] + gv[bj][n] * acc[ai][bj][m][n]; }
            }
    }
};
struct EpiSwiglu {
    static constexpr bool PERM = true;
    bf16_t* a;
    DI void operator()(const Acc& acc, const Unit& u, int wr, int wc, int fr, int fq) const {
#pragma unroll
        for (int ai = 0; ai < 2; ++ai)
#pragma unroll
            for (int m = 0; m < 4; ++m) { const int row = u.pm * 256 + ai * 128 + wr * 64 + m * 16 + fr;
                f32x4 g0 = acc[ai][0][m][0], g1 = acc[ai][0][m][1]; const f32x4 u0 = acc[ai][1][m][0], u1 = acc[ai][1][m][1];
                for (int j = 0; j < 4; ++j) { g0[j] = siluf_(g0[j]) * u0[j]; g1[j] = siluf_(g1[j]) * u1[j]; }
                *(u32x4*)(a + (size_t)row * FH + u.pn * 128 + wc * 32 + 8 * fq) = pack44(g0, g1); }
    }
};
}

template <int MODE> DI int rowmap(int n) {
    if (MODE == 1) return n < 5120 ? n : (n < 5136 ? 9216 + (n - 5120) : n - 16);
    if (MODE == 2) { if (n < 5632) return (n >> 7) * 256 + (n & 127); const int m = n - 5632; return (m >> 7) * 256 + 128 + (m & 127); }
    return n;
}
template <int MODE> DI void transpose_job(LAS unsigned char* lds, const float* src, int K, int N, bf16_t* dst, int bid, int nblk) {
    const int tid = TID(), tn = (N + 63) >> 6, tk = K >> 6, ntile = tn * tk;
    for (int t0 = bid; t0 < ntile; t0 += 2 * nblk) {
#pragma unroll
        for (int q = 0; q < 2; ++q) { const int t = t0 + q * nblk; LAS float* tl = (LAS float*)(lds + q * 16640);
            if (t < ntile) { const int k0 = (t / tn) * 64, n0 = (t % tn) * 64;
#pragma unroll
                for (int i = 0; i < 2; ++i) { const int kk = (tid >> 4) + 32 * i, nn = (tid & 15) * 4;
                    f32x4 v = {0.f, 0.f, 0.f, 0.f}; if (n0 + nn < N) v = *(const f32x4*)(src + (size_t)(k0 + kk) * N + n0 + nn);
                    tl[kk * 65 + nn] = v[0]; tl[kk * 65 + nn + 1] = v[1]; tl[kk * 65 + nn + 2] = v[2]; tl[kk * 65 + nn + 3] = v[3]; } } }
        lds_barrier();
#pragma unroll
        for (int q = 0; q < 2; ++q) { const int t = t0 + q * nblk; LAS float* tl = (LAS float*)(lds + q * 16640);
            if (t < ntile) { const int k0 = (t / tn) * 64, n0 = (t % tn) * 64, n = tid >> 3, ko = (tid & 7) * 8;
                if (n0 + n < N) { float f[8];
#pragma unroll
                    for (int jq = 0; jq < 8; ++jq) f[jq] = tl[(ko + jq) * 65 + n];
                    *(u32x4*)(dst + (size_t)rowmap<MODE>(n0 + n) * K + k0 + ko) = pack8(f); } } }
        lds_barrier();
    }
}

DI void phase_weights_a(LAS unsigned char* lds, PP p, int l, int bid, int nblk) {
    unsigned char* ws = p->ws;
    transpose_job<1>(lds, p->in[4] + (size_t)l * 2048 * 9232, 2048, 9232, (bf16_t*)(ws + O_WIN), bid, nblk);
    transpose_job<0>(lds, p->in[13] + (size_t)l * 1024 * 1024, 1024, 1024, (bf16_t*)(ws + O_WGLU), bid, nblk);
    transpose_job<0>(lds, p->in[19] + (size_t)l * 1024 * 2048, 1024, 2048, (bf16_t*)(ws + O_WUPS), bid, nblk);
    { u32x4* z = (u32x4*)(ws + O_WIN + (size_t)9232 * 2048 * 2); const int nz = 240 * 2048 * 2 / 16;
      for (int i = bid * NTHR + TID(); i < nz; i += nblk * NTHR) z[i] = (u32x4){0u, 0u, 0u, 0u}; }
}
DI void phase_weights_b(LAS unsigned char* lds, PP p, int l, int bid, int nblk) {
    unsigned char* ws = p->ws;
    transpose_job<0>(lds, p->in[20] + (size_t)l * 1024 * 2048, 1024, 2048, (bf16_t*)(ws + O_WUPG), bid, nblk);
    transpose_job<0>(lds, p->in[21] + (size_t)l * 2048 * 2048, 2048, 2048, (bf16_t*)(ws + O_WOUT), bid, nblk);
    transpose_job<2>(lds, p->in[24] + (size_t)l * 2048 * 11264, 2048, 11264, (bf16_t*)(ws + O_WF1), bid, nblk);
    transpose_job<0>(lds, p->in[25] + (size_t)l * 5632 * 2048, 5632, 2048, (bf16_t*)(ws + O_WF2), bid, nblk);
}

DI void phase_mod(LAS unsigned char* lds, PP p) {
    LAS float* red = (LAS float*)lds;
    const int tid = TID(), col = tid & 31, kp = tid >> 5;
    const float* c = p->in[1];
    float* mod = (float*)(p->ws + O_MOD);
    for (int u = BID(); u < 768; u += GDIM()) {
        const int l = u / 384, c0 = (u % 384) * 32;
        const float* w = p->in[2] + (size_t)l * 2048 * 12288 + c0 + col;
        float s = 0.f;
        for (int k = kp * 128; k < kp * 128 + 128; ++k) { const float cv = c[k]; s += (cv / (1.f + __expf(-cv))) * w[(size_t)k * 12288]; }
        red[kp * 32 + col] = s;
        __syncthreads();
        if (tid < 32) { float t = 0.f; for (int i = 0; i < 16; ++i) t += red[i * 32 + tid]; mod[l * 12288 + c0 + tid] = t + p->in[3][l * 12288 + c0 + tid]; }
        __syncthreads();
    }
}

DI void phase_s5pre(LAS unsigned char* lds, PP p, int l, int bid, int nblk) {
    LAS float* apr = (LAS float*)lds;
    LAS float* api = apr + 33 * 64;
    LAS float* bbr = api + 33 * 64;
    LAS float* bbi = bbr + 1024;
    LAS float* ccr = bbi + 1024;
    LAS float* cci = ccr + 1024;
    LAS float* kt = cci + 1024;
    const int tid = TID();
    bf16_t* bt2 = (bf16_t*)(p->ws + O_BT2); bf16_t* m2 = (bf16_t*)(p->ws + O_M2); float* a32 = (float*)(p->ws + O_A32);
    for (int g = bid; g < 64; g += nblk) {
        const float dt = expf(p->in[7][l * 64 + g]);
        for (int id = tid; id < 33 * 64; id += NTHR) { const int pp = id & 63, j = id >> 6;
            const float lr = p->in[5][(l * 64 + g) * 64 + pp], li = p->in[6][(l * 64 + g) * 64 + pp];
            const float mg = expf(lr * dt * (float)j), an = li * dt * (float)j; float sn, cs; sincosf(an, &sn, &cs); const float re = mg * cs, im = mg * sn;
            apr[j * 64 + pp] = re; api[j * 64 + pp] = im;
            if (j == 32) { a32[(g * 64 + pp) * 2] = re; a32[(g * 64 + pp) * 2 + 1] = im; } }
        for (int id = tid; id < 1024; id += NTHR) { const int pp = id >> 4, hi = id & 15;
            const float lr = p->in[5][(l * 64 + g) * 64 + pp], li = p->in[6][(l * 64 + g) * 64 + pp];
            const float mg = expf(lr * dt), an = li * dt; float sn, cs; sincosf(an, &sn, &cs); const float nr = mg * cs - 1.0f, ni = mg * sn, den = lr * lr + li * li;
            const float fr = (nr * lr + ni * li) / den, fi = (ni * lr - nr * li) / den;
            const size_t bo = ((size_t)(l * 64 + g) * 64 + pp) * 16 + hi; const float br = p->in[8][bo], bi = p->in[9][bo];
            bbr[id] = fr * br - fi * bi; bbi[id] = fr * bi + fi * br;
            const int ho = id >> 6, p2 = id & 63; const size_t co = ((size_t)(l * 64 + g) * 16 + ho) * 64 + p2;
            ccr[id] = p->in[10][co]; cci[id] = p->in[11][co]; }
        __syncthreads();
        for (int id = tid; id < 32 * 256; id += NTHR) { const int j = id >> 8, ho = (id >> 4) & 15, hi = id & 15; float s = 0.f;
            for (int pp = 0; pp < 64; ++pp) { const float ar = apr[j * 64 + pp], ai = api[j * 64 + pp], br = bbr[pp * 16 + hi], bi = bbi[pp * 16 + hi];
                const float wr_ = ar * br - ai * bi, wi_ = ar * bi + ai * br; s += ccr[ho * 64 + pp] * wr_ - cci[ho * 64 + pp] * wi_; }
            kt[id] = s; }
        __syncthreads();
        for (int id = tid; id < 512 * 80; id += NTHR) { const int n = id / 80, oc = id % 80, t = n >> 4, ho = n & 15; float f[8];
            if (oc < 64) { const int s = oc >> 1, hi0 = (oc & 1) * 8;
                for (int i = 0; i < 8; ++i) f[i] = (s <= t) ? kt[(t - s) * 256 + ho * 16 + hi0 + i] : 0.f;
            } else { for (int i = 0; i < 8; ++i) { const int cc = (oc - 64) * 8 + i, ri = cc >> 6, pp = cc & 63;
                const float ar = apr[(t + 1) * 64 + pp], ai = api[(t + 1) * 64 + pp], cr = ccr[ho * 64 + pp], ci = cci[ho * 64 + pp];
                f[i] = ri == 0 ? (cr * ar - ci * ai) : -(cr * ai + ci * ar); } }
            *(u32x4*)(bt2 + ((size_t)g * 512 + n) * 640 + oc * 8) = pack8(f); }
        for (int id = tid; id < 256 * 64; id += NTHR) { const int rr = id >> 6, oc = id & 63; float f[8];
            if (rr < 128) { const int ri = rr >> 6, pp = rr & 63, s = oc >> 1, hi0 = (oc & 1) * 8; const float ar = apr[(31 - s) * 64 + pp], ai = api[(31 - s) * 64 + pp];
                for (int i = 0; i < 8; ++i) { const float br = bbr[pp * 16 + hi0 + i], bi = bbi[pp * 16 + hi0 + i]; f[i] = ri == 0 ? (ar * br - ai * bi) : (ar * bi + ai * br); }
            } else { for (int i = 0; i < 8; ++i) f[i] = 0.f; }
            *(u32x4*)(m2 + ((size_t)g * 256 + rr) * 512 + oc * 8) = pack8(f); }
        __syncthreads();
    }
}

DI float wave_sum(float v) {
#pragma unroll
    for (int o = 32; o >= 1; o >>= 1) v += __shfl_xor(v, o);
    return v;
}
template <bool FIRST, bool SECOND, bool BR = false>
DI void phase_ln(const float* src, const float* g, const float* b, float* dst1, const float* sh, const float* sc, bf16_t* dsth, const bf16_t* ybr = nullptr) {
    const int wid = TID() >> 6, lane = TID() & 63;
    for (int row0 = (BID() * 8 + wid) * 2; row0 < L; row0 += GDIM() * 16) {
        float v[2][4][8];
#pragma unroll
        for (int rr = 0; rr < 2; ++rr)
#pragma unroll
            for (int i = 0; i < 4; ++i) { const float* sp = src + (size_t)(row0 + rr) * DM + i * 512 + lane * 8; const f32x4 a = *(const f32x4*)sp, c = *(const f32x4*)(sp + 4);
                v[rr][i][0] = a[0]; v[rr][i][1] = a[1]; v[rr][i][2] = a[2]; v[rr][i][3] = a[3]; v[rr][i][4] = c[0]; v[rr][i][5] = c[1]; v[rr][i][6] = c[2]; v[rr][i][7] = c[3]; }
        if (BR) {
#pragma unroll
            for (int rr = 0; rr < 2; ++rr)
#pragma unroll
                for (int i = 0; i < 4; ++i) { float yf[8]; unpack8(*(const u32x4*)(ybr + (size_t)(row0 + rr) * DM + i * 512 + lane * 8), yf);
                    for (int k = 0; k < 8; ++k) v[rr][i][k] = ALPHA * v[rr][i][k] + yf[k]; }
        }
        if (FIRST) {
            f32x4 P0[4][2], P1[4][2];
#pragma unroll
            for (int i = 0; i < 4; ++i) { const int c0 = i * 512 + lane * 8; P0[i][0] = *(const f32x4*)(g + c0); P0[i][1] = *(const f32x4*)(g + c0 + 4); P1[i][0] = *(const f32x4*)(b + c0); P1[i][1] = *(const f32x4*)(b + c0 + 4); }
#pragma unroll
            for (int rr = 0; rr < 2; ++rr) {
                float s = 0.f;
#pragma unroll
                for (int i = 0; i < 4; ++i) for (int k = 0; k < 8; ++k) s += v[rr][i][k];
                const float mu = wave_sum(s) * (1.f / DM); float q = 0.f;
#pragma unroll
                for (int i = 0; i < 4; ++i) for (int k = 0; k < 8; ++k) { const float d = v[rr][i][k] - mu; q += d * d; }
                const float rs = rsqrtf(wave_sum(q) * (1.f / DM) + 1e-5f);
#pragma unroll
                for (int i = 0; i < 4; ++i) { const int c0 = i * 512 + lane * 8;
                    for (int k = 0; k < 8; ++k) v[rr][i][k] = (v[rr][i][k] - mu) * rs * P0[i][k >> 2][k & 3] + P1[i][k >> 2][k & 3];
                    *(f32x4*)(dst1 + (size_t)(row0 + rr) * DM + c0) = (f32x4){v[rr][i][0], v[rr][i][1], v[rr][i][2], v[rr][i][3]};
                    *(f32x4*)(dst1 + (size_t)(row0 + rr) * DM + c0 + 4) = (f32x4){v[rr][i][4], v[rr][i][5], v[rr][i][6], v[rr][i][7]}; }
            }
        }
        if (SECOND) {
            f32x4 P0[4][2], P1[4][2];
#pragma unroll
            for (int i = 0; i < 4; ++i) { const int c0 = i * 512 + lane * 8; P0[i][0] = *(const f32x4*)(sc + c0); P0[i][1] = *(const f32x4*)(sc + c0 + 4); P1[i][0] = *(const f32x4*)(sh + c0); P1[i][1] = *(const f32x4*)(sh + c0 + 4); }
#pragma unroll
            for (int rr = 0; rr < 2; ++rr) {
                float s = 0.f;
#pragma unroll
                for (int i = 0; i < 4; ++i) for (int k = 0; k < 8; ++k) s += v[rr][i][k];
                const float mu = wave_sum(s) * (1.f / DM); float q = 0.f;
#pragma unroll
                for (int i = 0; i < 4; ++i) for (int k = 0; k < 8; ++k) { const float d = v[rr][i][k] - mu; q += d * d; }
                const float rs = rsqrtf(wave_sum(q) * (1.f / DM) + 1e-5f);
#pragma unroll
                for (int i = 0; i < 4; ++i) { const int c0 = i * 512 + lane * 8; float f[8];
                    for (int k = 0; k < 8; ++k) f[k] = (v[rr][i][k] - mu) * rs * (1.f + P0[i][k >> 2][k & 3]) + P1[i][k >> 2][k & 3];
                    *(u32x4*)(dsth + (size_t)(row0 + rr) * DM + c0) = pack8(f); }
            }
        }
    }
}

DI void phase_carry(PP p, int bid) {
    const int id = bid * NTHR + TID();
    if (id >= 4096) return;
    const int g = id >> 6, pp = id & 63;
    const float* a32 = (const float*)(p->ws + O_A32); const float* xe = (const float*)(p->ws + O_XEND) + (size_t)g * 512 * 128 + pp;
    bf16_t* up = (bf16_t*)(p->ws + O_E) + (size_t)g * 512 * 640 + 512 + pp;
    const float ar = a32[id * 2], ai = a32[id * 2 + 1];
    float xr = 0.f, xi = 0.f;
#pragma unroll 32
    for (int c = 0; c < 512; ++c) {
        up[(size_t)c * 640] = f2bf(xr); up[(size_t)c * 640 + 64] = f2bf(xi);
        const float er = xe[(size_t)c * 128], ei = xe[(size_t)c * 128 + 64];
        const float nr = ar * xr - ai * xi + er, ni = ar * xi + ai * xr + ei; xr = nr; xi = ni;
    }
}

constexpr int QN_O = 0, KN_O = 17408, XTK_O = 34816, XTV_O = 53248, KT2_O = 71680, TIMG_O = 90112, MM_O = 99328, AT_O = 116736, SC_O = 134144;
DI int xsw(int row, int col) { return row * 72 + ((((col >> 3) ^ (row >> 3)) & 7) << 3) + (col & 7); }
constexpr int CW_O = SC_O + 1024;
DI void gdn_intra(LAS unsigned char* lds, PP p, int l, int first, int stride) {
    { unsigned lb = (unsigned)(size_t)lds; asm volatile("" : "+v"(lb)); lds = (LAS unsigned char*)lb; }
    const float* logit = (const float*)(p->ws + O_LOG); const float* logit2 = (const float*)(p->ws + O_LOG2);
    const bf16_t* qkv = (const bf16_t*)(p->ws + O_QKV);
    const float* cw = p->in[15] + (size_t)l * 4 * 3072;
    float Wp[3]; float LG0 = 0.f, LG1 = 0.f; u32x4 R[24];
#define INTRA_LOADRAW(item_) do { const int hd_ = (item_) >> 8, t0_ = ((item_) & 255) * 64; \
        _Pragma("unroll") for (int mat = 0; mat < 3; ++mat) _Pragma("unroll") for (int it = 0; it < 2; ++it) _Pragma("unroll") for (int kk = 0; kk < 4; ++kk) { \
            const int id = tid + NTHR * it, j = id >> 4, o = id & 15; int t = t0_ + j - 3 + kk; t = t < 0 ? 0 : t; \
            R[(mat * 2 + it) * 4 + kk] = *(const u32x4*)(qkv + (size_t)t * 3072 + mat * 1024 + hd_ * 128 + o * 8); } } while (0)
#define INTRA_PREFETCH(item_) do { const int hd_ = (item_) >> 8, t0_ = ((item_) & 255) * 64; \
        _Pragma("unroll") for (int e = 0; e < 3; ++e) { const int idx = tid + NTHR * e, kk = idx / 384, c = idx - kk * 384; Wp[e] = cw[kk * 3072 + (c >> 7) * 1024 + hd_ * 128 + (c & 127)]; } \
        if (tid < 64) { const size_t lo_ = (size_t)(t0_ + tid) * 16 + hd_; LG0 = logit[lo_] + logit2[lo_]; LG1 = logit[lo_ + 8] + logit2[lo_ + 8]; } } while (0)
    if (first < 2048) { const int tid = TID(); INTRA_PREFETCH(first); INTRA_LOADRAW(first); }
    for (int item = first; item < 2048; item += stride) {
    const int tid = TID(), w = tid >> 6, lane = tid & 63, r = lane & 31, h = lane >> 5;
    { unsigned lb = (unsigned)(size_t)lds; asm volatile("" : "+v"(lb)); lds = (LAS unsigned char*)lb; }
    LAS bf16_t* Qn = (LAS bf16_t*)(lds + QN_O); LAS bf16_t* Kn = (LAS bf16_t*)(lds + KN_O);
    LAS bf16_t* XTk = (LAS bf16_t*)(lds + XTK_O); LAS bf16_t* XTv = (LAS bf16_t*)(lds + XTV_O); LAS bf16_t* KT2 = (LAS bf16_t*)(lds + KT2_O);
    LAS bf16_t* Timg = (LAS bf16_t*)(lds + TIMG_O); LAS float* Mm = (LAS float*)(lds + MM_O); LAS float* At = (LAS float*)(lds + AT_O);
    LAS float* scb = (LAS float*)(lds + SC_O); LAS float* scg = scb + 64; LAS float* sce = scb + 128; LAS float* scl = scb + 192;
    LAS float* CW = (LAS float*)(lds + CW_O);
    const int hd = item >> 8, n = item & 255, tok0 = n * 64;
    unsigned char* fb = p->ws + O_A + (size_t)item * FRAG_ITEM;
    unsigned char* ub = p->ws + O_UFR + (size_t)item * UFR_ITEM;
#pragma unroll
    for (int e = 0; e < 3; ++e) CW[tid + NTHR * e] = Wp[e];
    if (tid < 64) {
        const float bl = LG0, al = LG1;
        const float beta = 1.f / (1.f + __expf(-bl));
        const float xx = al + p->in[17][l * 8 + hd];
        const float ex = __expf(fminf(xx, 20.f));
        const float sp = xx > 20.f ? xx : (ex < 0.05f ? ex * (1.f - ex * (0.5f - ex * (0.33333333f - ex * 0.25f))) : __logf(1.f + ex));
        float gc = -__expf(p->in[16][l * 8 + hd]) * sp;
#pragma unroll
        for (int off = 1; off < 64; off <<= 1) { const float t = __shfl_up(gc, off); if (tid >= off) gc += t; }
        const float gl = __shfl(gc, 63);
        scb[tid] = beta; scg[tid] = gc; sce[tid] = __expf(gc); scl[tid] = __expf(gl - gc);
        if (tid == 0) ((float*)(p->ws + O_GL))[hd * 256 + n] = __expf(gl);
    }
    lds_barrier();
#pragma unroll
    for (int mat = 0; mat < 3; ++mat) {
#pragma unroll
        for (int it = 0; it < 2; ++it) {
            const int id = tid + NTHR * it, j = id >> 4, o = id & 15;
            float a[8];
#pragma unroll
            for (int i = 0; i < 8; ++i) a[i] = 0.f;
#pragma unroll
            for (int kk = 0; kk < 4; ++kk) { const bool ok = tok0 + j - 3 + kk >= 0;
                float x[8]; unpack8(R[(mat * 2 + it) * 4 + kk], x);
                const f32x4 w0 = *(const LAS f32x4*)(CW + kk * 384 + mat * 128 + o * 8), w1 = *(const LAS f32x4*)(CW + kk * 384 + mat * 128 + o * 8 + 4);
                for (int i = 0; i < 4; ++i) { a[i] += ok ? w0[i] * x[i] : 0.f; a[4 + i] += ok ? w1[i] * x[4 + i] : 0.f; } }
#pragma unroll
            for (int i = 0; i < 8; ++i) a[i] = a[i] / (1.f + __expf(-a[i]));
            if (mat < 2) {
                float ss = 0.f;
#pragma unroll
                for (int i = 0; i < 8; ++i) ss += a[i] * a[i];
                ss += __shfl_xor(ss, 1); ss += __shfl_xor(ss, 2); ss += __shfl_xor(ss, 4); ss += __shfl_xor(ss, 8);
                const float sc = rsqrtf(ss + 1e-6f) * (mat == 0 ? 0.08838834764831845f : 1.f);
#pragma unroll
                for (int i = 0; i < 8; ++i) a[i] *= sc;
            }
            if (mat == 0) {
                *(LAS u32x4*)(Qn + j * 136 + o * 8) = pack8(a);
                const float eg = sce[j]; const int ct = j >> 5, s = o >> 1, part = o & 1;
                unsigned char* q0 = fb + 16384 + ((size_t)((ct * 8 + s) * 64 + (j & 31))) * 16 + 8 * part;
                u32x2 lo, hi2; lo.x = pk2(a[0] * eg, a[1] * eg); lo.y = pk2(a[2] * eg, a[3] * eg); hi2.x = pk2(a[4] * eg, a[5] * eg); hi2.y = pk2(a[6] * eg, a[7] * eg);
                *(u32x2*)q0 = lo; *(u32x2*)(q0 + 32 * 16) = hi2;
            } else if (mat == 1) {
                *(LAS u32x4*)(Kn + j * 136 + o * 8) = pack8(a);
                const float f1 = scb[j] * sce[j], f2 = scl[j];
#pragma unroll
                for (int i = 0; i < 8; ++i) { XTk[xsw(o * 8 + i, j)] = f2bf(a[i] * f1); KT2[xsw(o * 8 + i, j)] = f2bf(a[i] * f2); }
            } else {
                const float f1 = scb[j];
#pragma unroll
                for (int i = 0; i < 8; ++i) XTv[xsw(o * 8 + i, j)] = f2bf(a[i] * f1);
            }
            __builtin_amdgcn_sched_barrier(0);
        }
    }
    { const int nxt = item + stride; if (nxt < 2048) { INTRA_PREFETCH(nxt); INTRA_LOADRAW(nxt); } }
    lds_barrier();
    {
        const int isq = w >> 2, it = (w & 3) >> 1, jt = w & 1;
        LAS bf16_t* Ai = isq ? Qn : Kn;
        f32x16 acc; for (int i = 0; i < 16; ++i) acc[i] = 0.f;
#pragma unroll
        for (int s = 0; s < 8; ++s) { const bf16x8 a = *(const LAS bf16x8*)(Ai + (32 * it + r) * 136 + 16 * s + 8 * h), b = *(const LAS bf16x8*)(Kn + (32 * jt + r) * 136 + 16 * s + 8 * h);
            acc = MFMA32(a, b, acc); }
        const int col = 32 * jt + r; const float gcc = scg[col];
#pragma unroll
        for (int i = 0; i < 16; ++i) { const int row = 32 * it + crow(i, h);
            if (isq) At[row * 68 + col] = (row >= col) ? acc[i] * __expf(scg[row] - gcc) : 0.f;
            else Mm[row * 68 + col] = (row > col) ? scb[row] * acc[i] * __expf(scg[row] - gcc) : 0.f; }
    }
    lds_barrier();
    LAS float* T22f = (LAS float*)(lds + QN_O);
    if (w < 2) {
        float t[32];
        const int base = 32 * w; const float cf = (float)r;
#pragma unroll
        for (int i = 0; i < 32; ++i) {
            float a0 = fmaxf(0.f, 1.f - fabsf(cf - (float)i)), a1 = 0.f;
#pragma unroll
            for (int j4 = 0; j4 < (i + 3) / 4; ++j4) { const f32x4 mv = *(const LAS f32x4*)(Mm + (base + i) * 68 + base + j4 * 4);
#pragma unroll
                for (int jj = 0; jj < 4; ++jj) { const int j = j4 * 4 + jj; if (j < i) { if (jj & 1) a1 -= mv[jj] * t[j]; else a0 -= mv[jj] * t[j]; } } }
            t[i] = a0 + a1;
            asm volatile("" : "+v"(t[i]) :: "memory");
        }
#pragma unroll
        for (int i = 0; i < 32; ++i) {
            if (h == 0) Timg[(base + i) * 72 + base + r] = f2bf(t[i]);
            else if (w == 1) Timg[i * 72 + 32 + r] = 0;
            if (w == 1 && h == 0) T22f[i * 33 + r] = t[i];
        }
        lds_barrier();
        if (w == 0) {
            unsigned hmask = h ? 0xffffffffu : 0u; asm volatile("" : "+v"(hmask));
            f32x16 X; for (int i = 0; i < 16; ++i) X[i] = 0.f;
#pragma unroll
            for (int m = 0; m < 16; ++m) { const float a = Mm[(32 + r) * 68 + 2 * m + h]; const float b = __uint_as_float((__float_as_uint(t[2 * m]) & ~hmask) | (__float_as_uint(t[2 * m + 1]) & hmask));
                X = __builtin_amdgcn_mfma_f32_32x32x2f32(a, b, X, 0, 0, 0); }
            f32x16 Y; for (int i = 0; i < 16; ++i) Y[i] = 0.f;
#pragma unroll
            for (int m = 0; m < 16; ++m) { const float a = T22f[r * 33 + crow(m, h)];
                Y = __builtin_amdgcn_mfma_f32_32x32x2f32(a, X[m], Y, 0, 0, 0); }
#pragma unroll
            for (int i = 0; i < 16; ++i) Timg[(32 + crow(i, h)) * 72 + r] = f2bf(-Y[i]);
        }
    } else {
        for (int id = tid - 128; id < 1536; id += 384) {
            const int ln = id & 63, rr = ln & 31, hh = ln >> 5;
            if (id < 1024) { const int f = id >> 6, dt = f >> 2, s = f & 3; const int d = 32 * dt + rr;
                const u32x2 lo = *(const LAS u32x2*)(KT2 + xsw(d, 16 * s + 4 * hh)), hi2 = *(const LAS u32x2*)(KT2 + xsw(d, 16 * s + 8 + 4 * hh));
                *(u32x4*)(fb + 40960 + (size_t)(f * 64 + ln) * 16) = (u32x4){lo.x, lo.y, hi2.x, hi2.y};
            } else { const int f = (id - 1024) >> 6, ct = f >> 2, s = f & 3; const int row = 32 * ct + rr;
                const f32x4 lo = *(const LAS f32x4*)(At + row * 68 + 16 * s + 4 * hh), hi2 = *(const LAS f32x4*)(At + row * 68 + 16 * s + 8 + 4 * hh);
                *(u32x4*)(fb + 32768 + (size_t)(f * 64 + ln) * 16) = pack44(lo, hi2); }
        }
        lds_barrier();
    }
    lds_barrier();
    {
        const int ct = w >> 2, et = w & 3;
        f32x16 acc; for (int i = 0; i < 16; ++i) acc[i] = 0.f;
#pragma unroll
        for (int s = 0; s < 4; ++s) { const bf16x8 a = *(const LAS bf16x8*)(Timg + (32 * ct + r) * 72 + 16 * s + 8 * h), b = *(const LAS bf16x8*)(XTv + xsw(32 * et + r, 16 * s + 8 * h));
            acc = MFMA32(a, b, acc); }
        unsigned char* ud = ub + (size_t)(ct * 4 + et) * 4096 + lane * 16;
#pragma unroll
        for (int q = 0; q < 4; ++q) *(f32x4*)(ud + q * 1024) = (f32x4){acc[4 * q], acc[4 * q + 1], acc[4 * q + 2], acc[4 * q + 3]};
        const int dt = w >> 1, c2 = w & 1;
        f32x16 ac2; for (int i = 0; i < 16; ++i) ac2[i] = 0.f;
#pragma unroll
        for (int s = 0; s < 4; ++s) { const bf16x8 a = *(const LAS bf16x8*)(XTk + xsw(32 * dt + r, 16 * s + 8 * h)), b = *(const LAS bf16x8*)(Timg + (32 * c2 + r) * 72 + 16 * s + 8 * h);
            ac2 = MFMA32(a, b, ac2); }
#pragma unroll
        for (int sp = 0; sp < 2; ++sp) { u32x4 wv; wv.x = pk2(ac2[8 * sp], ac2[8 * sp + 1]); wv.y = pk2(ac2[8 * sp + 2], ac2[8 * sp + 3]); wv.z = pk2(ac2[8 * sp + 4], ac2[8 * sp + 5]); wv.w = pk2(ac2[8 * sp + 6], ac2[8 * sp + 7]);
            *(u32x4*)(fb + (size_t)((c2 * 8 + 2 * dt + sp) * 64 + lane) * 16) = wv; }
    }
    lds_barrier();
    }
#undef INTRA_PREFETCH
#undef INTRA_LOADRAW
}

DI void gdn_scan(LAS unsigned char* lds, PP p, int wg) {
    const int tid = TID(), w = tid >> 6, lane = tid & 63, r = lane & 31, h = lane >> 5;
    const int hd = wg >> 2, cb = wg & 3, rt = w & 3; const bool act = w < 4;
    LAS u32x4* Simg = (LAS u32x4*)lds;
    LAS u32x4* Vimg = (LAS u32x4*)(lds + 8192);
    LAS bf16_t* Oimg = (LAS bf16_t*)(lds + 12288);
    f32x16 S; for (int i = 0; i < 16; ++i) S[i] = 0.f;
    if (act) { Simg[(2 * rt) * 64 + lane] = (u32x4){0u, 0u, 0u, 0u}; Simg[(2 * rt + 1) * 64 + lane] = (u32x4){0u, 0u, 0u, 0u}; }
    lds_barrier();
    const unsigned char* fb = p->ws + O_A + (size_t)(hd * 256) * FRAG_ITEM;
    const unsigned char* ub = p->ws + O_UFR + (size_t)(hd * 256) * UFR_ITEM;
    const float* GL = (const float*)(p->ws + O_GL) + hd * 256;
    bf16_t* obf = (bf16_t*)(p->ws + O_OBF);
    const size_t a1off = (rt < 2 ? 0 : 16384) + (size_t)((rt & 1) * 8) * 1024 + lane * 16;
    const size_t ktoff = 40960 + (size_t)(rt * 4) * 1024 + lane * 16;
    const unsigned char* xbase = rt >= 2 ? fb + 32768 + (size_t)((rt & 1) * 4) * 1024 + lane * 16 : ub + (size_t)((rt & 1) * 4 + cb) * 4096 + lane * 16;
    const size_t xitem = rt >= 2 ? FRAG_ITEM : UFR_ITEM;
#define GLD16(dst, ptr) asm volatile("global_load_dwordx4 %0, %1, off" : "=v"(dst) : "v"(ptr) : "memory")
#define TIE8(NSTR, a, b) asm volatile("s_waitcnt vmcnt(" NSTR ")" : "+v"(a[0]), "+v"(a[1]), "+v"(a[2]), "+v"(a[3]), "+v"(b[0]), "+v"(b[1]), "+v"(b[2]), "+v"(b[3]) :: "memory")
#define SCAN_WAIT_A1(A1_) do { if (rt >= 2) { TIE8("28", A1_, (A1_ + 4)); } else { TIE8("24", A1_, (A1_ + 4)); } } while (0)
#define SCAN_WAIT_X(KT_, X_) do { if (rt >= 2) { TIE8("28", KT_, X_); } else { TIE8("24", KT_, X_); } } while (0)
#define SCAN_LOAD_A1(A1_, n_) do { const unsigned char* f_ = fb + (size_t)(n_) * FRAG_ITEM + a1off; \
        _Pragma("unroll") for (int s = 0; s < 8; ++s) GLD16(A1_[s], f_ + s * 1024); } while (0)
#define SCAN_LOAD_X(KT_, X_, n_) do { const unsigned char* f_ = fb + (size_t)(n_) * FRAG_ITEM + ktoff; const unsigned char* x_ = xbase + (size_t)(n_) * xitem; \
        _Pragma("unroll") for (int s = 0; s < 4; ++s) GLD16(KT_[s], f_ + s * 1024); \
        _Pragma("unroll") for (int s = 0; s < 4; ++s) GLD16(X_[s], x_ + s * 1024); } while (0)
#define SCAN_STEP(n_, A1_, KT_, X_) do { \
        const int nq_ = (n_); const float gsel_ = nq_ < 64 ? glr0 : (nq_ < 128 ? glr1 : (nq_ < 192 ? glr2 : glr3)); \
        const float gl = __int_as_float(__builtin_amdgcn_readlane(__float_as_int(gsel_), nq_ & 63)); const int n2_ = (n_) + 2 < 256 ? (n_) + 2 : 255; \
        f32x16 acc; for (int i = 0; i < 16; ++i) acc[i] = 0.f; \
        if (act) { \
            SCAN_WAIT_A1(A1_); \
            _Pragma("unroll") for (int s = 0; s < 8; ++s) { const bf16x8 b = __builtin_bit_cast(bf16x8, Simg[s * 64 + lane]); acc = MFMA32(__builtin_bit_cast(bf16x8, A1_[s]), b, acc); } \
            asm volatile("" : "+v"(acc)); \
            SCAN_LOAD_A1(A1_, n2_); \
            SCAN_WAIT_X(KT_, X_); \
            if (rt < 2) { \
                _Pragma("unroll") for (int sp = 0; sp < 2; ++sp) { float v[8]; \
                    _Pragma("unroll") for (int j = 0; j < 8; ++j) v[j] = __builtin_bit_cast(f32x4, X_[(8 * sp + j) >> 2])[(8 * sp + j) & 3] - acc[8 * sp + j]; \
                    Vimg[(2 * rt + sp) * 64 + lane] = pack8(v); } } } \
        lds_barrier(); \
        if (act) { \
            _Pragma("unroll") for (int i = 0; i < 16; ++i) S[i] *= gl; \
            _Pragma("unroll") for (int s = 0; s < 4; ++s) { const bf16x8 b = __builtin_bit_cast(bf16x8, Vimg[s * 64 + lane]); S = MFMA32(__builtin_bit_cast(bf16x8, KT_[s]), b, S); \
                if (rt >= 2) acc = MFMA32(__builtin_bit_cast(bf16x8, X_[s]), b, acc); } \
            asm volatile("" : "+v"(acc), "+v"(S)); \
            SCAN_LOAD_X(KT_, X_, n2_); \
            if (rt >= 2) { LAS bf16_t* oi_ = Oimg + (rt - 2) * 1280;     \
                _Pragma("unroll") for (int i = 0; i < 16; ++i) oi_[crow(i, h) * 40 + r] = f2bf(acc[i]); \
                _Pragma("unroll") for (int q = 0; q < 2; ++q) { const int pc = lane + 64 * q, row = pc >> 2, ch = pc & 3; \
                    const u32x4 ov = *(const LAS u32x4*)(oi_ + row * 40 + ch * 8); \
                    *(u32x4*)(obf + (size_t)(64 * (n_) + 32 * (rt - 2) + row) * 1024 + hd * 128 + 32 * cb + ch * 8) = ov; } } \
            _Pragma("unroll") for (int sp = 0; sp < 2; ++sp) { float v[8]; \
                _Pragma("unroll") for (int j = 0; j < 8; ++j) v[j] = S[8 * sp + j]; \
                Simg[(2 * rt + sp) * 64 + lane] = pack8(v); } } \
        lds_barrier(); } while (0)
    u32x4 A1a[8], A1b[8], KTa[4], KTb[4], Xa[4], Xb[4];
    const float glr0 = GL[lane], glr1 = GL[64 + lane], glr2 = GL[128 + lane], glr3 = GL[192 + lane];
    asm volatile("s_waitcnt vmcnt(0)" ::: "memory");
    SCAN_LOAD_A1(A1a, 0); SCAN_LOAD_X(KTa, Xa, 0); SCAN_LOAD_A1(A1b, 1); SCAN_LOAD_X(KTb, Xb, 1);
    TIE8("0", A1a, (A1a + 4)); TIE8("0", KTa, Xa); TIE8("0", A1b, (A1b + 4)); TIE8("0", KTb, Xb);
    for (int n = 0; n < 256; n += 2) {
        SCAN_STEP(n, A1a, KTa, Xa);
        SCAN_STEP(n + 1, A1b, KTb, Xb);
    }
    asm volatile("s_waitcnt vmcnt(0)" ::: "memory");
#undef GLD16
#undef TIE8
#undef SCAN_WAIT_A1
#undef SCAN_WAIT_X
#undef SCAN_LOAD_A1
#undef SCAN_LOAD_X
#undef SCAN_STEP
}

DI void phase_normgate(PP p, int l, int nblk, int bid) {
    bf16_t* obf = (bf16_t*)(p->ws + O_OBF); const bf16_t* z = (const bf16_t*)(p->ws + O_Z);
    const int o8 = TID() & 15;
    const f32x4 w0 = *(const f32x4*)(p->in[18] + l * 128 + o8 * 8), w1 = *(const f32x4*)(p->in[18] + l * 128 + o8 * 8 + 4);
    for (int grp0 = bid * 128 + (TID() >> 4); grp0 < L * 8; grp0 += nblk * 128) {
        u32x4 ov[4], zv[4];
#pragma unroll
        for (int q = 0; q < 4; ++q) { const int grp = grp0 + 32 * q; const size_t base = (size_t)(grp >> 3) * 1024 + (grp & 7) * 128 + o8 * 8;
            ov[q] = *(const u32x4*)(obf + base); zv[q] = *(const u32x4*)(z + base); }
#pragma unroll
        for (int q = 0; q < 4; ++q) { const int grp = grp0 + 32 * q; const size_t base = (size_t)(grp >> 3) * 1024 + (grp & 7) * 128 + o8 * 8;
            float o[8], zz[8]; unpack8(ov[q], o); unpack8(zv[q], zz);
            float ss = 0.f;
#pragma unroll
            for (int i = 0; i < 8; ++i) ss += o[i] * o[i];
            ss += __shfl_xor(ss, 1); ss += __shfl_xor(ss, 2); ss += __shfl_xor(ss, 4); ss += __shfl_xor(ss, 8);
            const float sc = rsqrtf(ss * (1.f / 128.f) + 1e-6f);
#pragma unroll
            for (int i = 0; i < 4; ++i) { o[i] = o[i] * sc * w0[i] * siluf_(zz[i]); o[4 + i] = o[4 + i] * sc * w1[i] * siluf_(zz[4 + i]); }
            *(u32x4*)(obf + base) = pack8(o); }
    }
}

__global__ void __launch_bounds__(512, 2) hybrid_fwd(Params p_arg) {
    extern __shared__ __attribute__((aligned(16))) unsigned char shm[];
    LAS unsigned char* lds = (LAS unsigned char*)shm;
    cg::grid_group grid = cg::this_grid();
    using namespace pg8;
    const unsigned my_xcc = xcc_id();
    if (__builtin_amdgcn_workitem_id_x() == 0) __hip_atomic_fetch_add((unsigned*)(p_arg.ws + O_BAR) + 512 + 64 * my_xcc, 1u, __ATOMIC_RELAXED, __HIP_MEMORY_SCOPE_AGENT);
    unsigned nx_mine = 0, nxcc_act = 0;
    for (int st = 0; st < 24; ++st) {
        const int l = st < 2 ? 0 : (st - 2) / 11;
        const int ph = st < 2 ? st : 2 + (st - 2) % 11;
        PP p = (PP)__builtin_amdgcn_kernarg_segment_ptr();
        asm volatile("" : "+s"(p));
        const int G = GDIM(), bid = BID();
        unsigned char* ws = p->ws;
        float* mod = (float*)(ws + O_MOD);
        bf16_t* hbuf = (bf16_t*)(ws + O_D);
        bf16_t* ybuf = (bf16_t*)(ws + O_B);
        float* x1buf = (float*)(ws + O_C);
        const float* ml = mod + l * 12288;
        switch (ph) {
        case 0:
            phase_mod(lds, p); if (bid < G - 64) phase_weights_a(lds, p, 0, bid, G - 64); else phase_s5pre(lds, p, 0, bid - (G - 64), 64);
            break;
        case 1:
            phase_ln<false, true>(p->in[0], nullptr, nullptr, nullptr, mod + 0, mod + 2048, hbuf);
            break;
        case 2: case 3:
            if (ph == 3 && bid < 128) { Gemm g{(const bf16_t*)(ws + O_E), (const bf16_t*)(ws + O_M2), 640, 512, 512}; OrderS5X S{128, bid}; EpiXend E{(float*)(ws + O_XEND)};
                gemm_phase(lds, g, S, E); }
            else { const int kh = ph == 3 ? (bid - 128) >> 6 : 0;
                Gemm g{hbuf + kh * 1024, (const bf16_t*)(ws + O_WIN) + kh * 1024, DM, DM, ph == 3 ? 1024 : DM}; OrderProj S; S.init(L, NPROJ - 256, G, ph == 3 ? (bid - 128) & 63 : bid); S.logit = ph == 3;
                EpiProj E{(bf16_t*)(ws + O_E), (bf16_t*)(ws + O_QKV), (bf16_t*)(ws + O_Z), (bf16_t*)(ws + O_SGS), (bf16_t*)(ws + O_SGG), (float*)(ws + (kh ? O_LOG2 : O_LOG))};
                gemm_phase(lds, g, S, E); }
            break;
        case 4:
            if (bid < 8) phase_carry(p, bid);
            else gdn_intra(lds, p, l, bid - 8, G - 8);
            break;
        case 5:
            if (bid < 32) gdn_scan(lds, p, bid);
            else {
                const int G2 = G - 32, c2 = bid - 32; unsigned* sb = (unsigned*)(ws + O_BAR) + 1280;
                { Gemm g{(const bf16_t*)(ws + O_E), (const bf16_t*)(ws + O_BT2), 640, 640, 640}; OrderS5Y S{G2, c2};
                  EpiS5Y E{(const bf16_t*)(ws + O_E), p->in[12] + l * 1024, (bf16_t*)(ws + O_ZS)}; gemm_phase(lds, g, S, E); }
                subbar(sb, (unsigned)((3 * l + 1) * G2));
                { Gemm g{(const bf16_t*)(ws + O_ZS), (const bf16_t*)(ws + O_WGLU), 1024, 1024, 1024}; StaticOrder S; S.init(L, 1024, G2, c2);
                  EpiGlu E{(const bf16_t*)(ws + O_ZS), p->in[14] + l * 1024, (bf16_t*)(ws + O_Y2)}; gemm_phase(lds, g, S, E); }
                subbar(sb, (unsigned)((3 * l + 2) * G2));
                { Gemm g{(const bf16_t*)(ws + O_Y2), (const bf16_t*)(ws + O_WUPS), 1024, 1024, 1024}; StaticOrder S; S.init(L, 2048, G2, c2);
                  EpiUp<0> E{(const bf16_t*)(ws + O_SGS), nullptr, (bf16_t*)(ws + O_T1)}; gemm_phase(lds, g, S, E); }
                __syncthreads();
                phase_weights_b(lds, p, l, c2, G2);
                if (l == 0) {
                    subbar(sb, (unsigned)(3 * G2));
                    phase_weights_a(lds, p, 1, c2, G2);
                    phase_s5pre(lds, p, 1, c2, G2);
                }
            }
            break;
        case 6:
            phase_normgate(p, l, G, bid);
            break;
        case 7: {
            Gemm g{(const bf16_t*)(ws + O_OBF), (const bf16_t*)(ws + O_WUPG), 1024, 1024, 1024}; StaticOrder S; S.init(L, 2048, G, bid);
            EpiUp<1> E{(const bf16_t*)(ws + O_SGG), (const bf16_t*)(ws + O_T1), (bf16_t*)(ws + O_MRG)}; gemm_phase(lds, g, S, E); } break;
        case 8: {
            const float* xin = l == 0 ? p->in[0] : p->out;
            Gemm g{(const bf16_t*)(ws + O_MRG), (const bf16_t*)(ws + O_WOUT), DM, DM, DM}; StaticOrder S; S.init(L, DM, G, bid);
            EpiBranch E{ml + 4096, ybuf}; gemm_phase(lds, g, S, E); (void)xin; } break;
        case 9:
            phase_ln<true, true, true>(l == 0 ? p->in[0] : p->out, p->in[22] + l * DM, p->in[23] + l * DM, x1buf, ml + 6144, ml + 8192, hbuf, ybuf);
            break;
        case 10: {
            Gemm g{hbuf, (const bf16_t*)(ws + O_WF1), DM, DM, DM}; StaticOrder S; S.init(L, 2 * FH, G, bid);
            EpiSwiglu E{(bf16_t*)(ws + O_A)}; gemm_phase(lds, g, S, E); } break;
        case 11: {
            Gemm g{(const bf16_t*)(ws + O_A), (const bf16_t*)(ws + O_WF2), FH, FH, FH}; StaticOrder S; S.init(L, DM, G, bid);
            EpiBranch E{ml + 10240, ybuf}; gemm_phase(lds, g, S, E); } break;
        default:
            if (l == 0) {
                phase_ln<true, true, true>(x1buf, p->in[26], p->in[27], p->out, mod + 12288, mod + 12288 + 2048, hbuf, ybuf);
            } else {
                phase_ln<true, false, true>(x1buf, p->in[26] + DM, p->in[27] + DM, p->out, nullptr, nullptr, nullptr, ybuf);
            }
            break;
        }
        if (st == 0) {
            if (G == 0x7fffffff) grid.sync();
            subbar((unsigned*)(ws + O_BAR) + 1472, (unsigned)G);
            unsigned* bar = (unsigned*)(ws + O_BAR);
            for (int x = 0; x < 8; ++x) { const unsigned c = __hip_atomic_load(bar + 512 + 64 * x, __ATOMIC_RELAXED, __HIP_MEMORY_SCOPE_AGENT); nxcc_act += c ? 1u : 0u; if (x == (int)my_xcc) nx_mine = c; }
        } else if (st != 23) gbar((unsigned*)(ws + O_BAR), (unsigned)st, nx_mine, nxcc_act, my_xcc);
    }
}

extern "C" void kernel_launch(void* const* d_in, const int* in_sizes, int n_in, void* d_out, int out_size, void* d_ws, size_t ws_size, hipStream_t stream) {
    static int grid_blocks = 0;
    if (grid_blocks == 0) {
        if (n_in != 28 || ws_size < WS_END) { fprintf(stderr, "kernel_launch: need 28 inputs and %zu bytes of workspace; got %d, %zu\n", (size_t)WS_END, n_in, ws_size); grid_blocks = -1; return; }
        int dev = 0, cus = 0, per_cu = 0;
        hipGetDevice(&dev);
        hipDeviceGetAttribute(&cus, hipDeviceAttributeMultiprocessorCount, dev);
        if (hipFuncSetAttribute((const void*)hybrid_fwd, hipFuncAttributeMaxDynamicSharedMemorySize, LDS_BYTES) != hipSuccess) { fprintf(stderr, "kernel_launch: hipFuncSetAttribute failed\n"); grid_blocks = -1; return; }
        hipOccupancyMaxActiveBlocksPerMultiprocessor(&per_cu, (const void*)hybrid_fwd, NTHR, LDS_BYTES);
        if (per_cu < 1) { fprintf(stderr, "kernel_launch: occupancy query says %d blocks per CU\n", per_cu); per_cu = 1; }
        (void)hipGetLastError();
        grid_blocks = cus;
    }
    if (grid_blocks < 0) return;
    Params p{};
    for (int i = 0; i < 28; ++i) p.in[i] = (const float*)d_in[i];
    p.out = (float*)d_out; p.ws = (unsigned char*)d_ws;
    if (hipMemsetAsync((char*)d_ws + O_BAR, 0, 8192, stream) != hipSuccess) { fprintf(stderr, "kernel_launch: hipMemsetAsync failed\n"); return; }
    void* args[] = {&p};
    hipError_t e = hipLaunchCooperativeKernel((const void*)hybrid_fwd, dim3(grid_blocks), dim3(NTHR), args, LDS_BYTES, stream);
    if (e != hipSuccess) fprintf(stderr, "cooperative launch failed: %s (grid %d)\n", hipGetErrorString(e), grid_blocks);
}
```

```cpp
#include <hip/hip_runtime.h>
#include <hip/hip_cooperative_groups.h>
#include <cstdio>
namespace cg = cooperative_groups;

#define LAS __attribute__((address_space(3)))
#define DI __device__ __forceinline__
typedef unsigned short bf16_t;
typedef short bf16x8 __attribute__((ext_vector_type(8)));
typedef float f32x2 __attribute__((ext_vector_type(2)));
typedef float f32x4 __attribute__((ext_vector_type(4)));
typedef float f32x16 __attribute__((ext_vector_type(16)));
typedef unsigned u32x4 __attribute__((ext_vector_type(4)));
typedef unsigned u32x2 __attribute__((ext_vector_type(2)));
typedef __bf16 bf2_t __attribute__((ext_vector_type(2)));

constexpr int L = 16384, DM = 2048, NPROJ = 9472, FH = 5632, NTHR = 512;
constexpr float ALPHA = 1.41421356237f;
constexpr int LDS_BYTES = 143360;

constexpr size_t SZ_WIN = (size_t)NPROJ * DM * 2, SZ_WGLU = 1024ull * 1024 * 2, SZ_WUP = 2048ull * 1024 * 2, SZ_WOUT = 2048ull * 2048 * 2,
                 SZ_WF1 = 11264ull * 2048 * 2, SZ_WF2 = 2048ull * 5632 * 2;
constexpr size_t O_WIN = 0, O_WGLU = O_WIN + SZ_WIN, O_WUPS = O_WGLU + SZ_WGLU, O_WUPG = O_WUPS + SZ_WUP, O_WOUT = O_WUPG + SZ_WUP,
                 O_WF1 = O_WOUT + SZ_WOUT, O_WF2 = O_WF1 + SZ_WF1;
constexpr size_t SZ_BT2 = 64ull * 512 * 640 * 2, SZ_M2 = 64ull * 256 * 512 * 2;
constexpr size_t O_BT2 = O_WF2 + SZ_WF2, O_M2 = O_BT2 + SZ_BT2;
constexpr size_t SZ_A = (size_t)L * FH * 2;
constexpr size_t O_A = O_M2 + SZ_M2;
constexpr size_t FRAG_ITEM = 57344, UFR_ITEM = 32768;
constexpr size_t O_UFR = O_A + 2048 * FRAG_ITEM;
constexpr size_t O_MRG = O_A;
constexpr size_t SZ_B = (size_t)L * DM * 4;
constexpr size_t O_B = O_A + SZ_A, O_QKV = O_B, O_Z = O_B + (size_t)L * 3072 * 2;
constexpr size_t O_Y2 = O_QKV, O_T1 = O_QKV + (size_t)L * 1024 * 2;
constexpr size_t O_C = O_B + SZ_B, O_SGS = O_C, O_SGG = O_C + (size_t)L * 2048 * 2;
constexpr size_t O_D = O_C + 2 * (size_t)L * 2048 * 2;
constexpr size_t O_ZS = O_D, O_OBF = O_D + (size_t)L * 1024 * 2;
constexpr size_t O_E = O_D + (size_t)L * 2048 * 2;
constexpr size_t O_LOG = O_E + 64ull * 512 * 640 * 2;
constexpr size_t O_XEND = O_LOG + (size_t)L * 16 * 4;
constexpr size_t O_MOD = O_XEND + 64ull * 512 * 128 * 4;
constexpr size_t O_A32 = O_MOD + 2 * 12288 * 4;
constexpr size_t O_GL = O_A32 + 64 * 64 * 2 * 4;
constexpr size_t O_BAR = O_GL + 8 * 256 * 4;
constexpr size_t O_LOG2 = O_BAR + 8192;
constexpr size_t WS_END = O_LOG2 + (size_t)L * 16 * 4;

struct Params {
    const float* in[28];
    float* out;
    unsigned char* ws;
};

extern "C" __device__ size_t __ockl_get_num_groups(unsigned);
typedef const __attribute__((address_space(4))) Params* PP;
DI int TID() { int t = __builtin_amdgcn_workitem_id_x(); asm volatile("" : "+v"(t)); return t; }
DI int GDIM() { return (int)__ockl_get_num_groups(0); }
DI int BID() { int t = __builtin_amdgcn_workgroup_id_x(); asm volatile("" : "+s"(t)); return t; }
DI unsigned pk2(float lo, float hi) { f32x2 v = {lo, hi}; bf2_t b = __builtin_convertvector(v, bf2_t); return __builtin_bit_cast(unsigned, b); }
DI bf16_t f2bf(float f) { return (bf16_t)(pk2(f, 0.f) & 0xffffu); }
DI float bflo(unsigned w) { return __uint_as_float(w << 16); }
DI float bfhi(unsigned w) { return __uint_as_float(w & 0xffff0000u); }
DI void unpack8(u32x4 w, float* f) { f[0] = bflo(w.x); f[1] = bfhi(w.x); f[2] = bflo(w.y); f[3] = bfhi(w.y); f[4] = bflo(w.z); f[5] = bfhi(w.z); f[6] = bflo(w.w); f[7] = bfhi(w.w); }
DI u32x4 pack8(const float* f) { u32x4 w; w.x = pk2(f[0], f[1]); w.y = pk2(f[2], f[3]); w.z = pk2(f[4], f[5]); w.w = pk2(f[6], f[7]); return w; }
DI u32x4 pack44(f32x4 a, f32x4 b) { u32x4 w; w.x = pk2(a[0], a[1]); w.y = pk2(a[2], a[3]); w.z = pk2(b[0], b[1]); w.w = pk2(b[2], b[3]); return w; }
DI float sigmoidf_(float x) { return 1.f / (1.f + __expf(-x)); }
DI float siluf_(float x) { return x / (1.f + __expf(-x)); }
DI float gelu_tanh(float y) { float t = 0.7978845608f * (y + 0.044715f * y * y * y); float e = __expf(2.f * t); return 0.5f * y * (2.f - 2.f / (e + 1.f)); }
DI void lds_barrier() { asm volatile("s_waitcnt lgkmcnt(0)" ::: "memory"); __builtin_amdgcn_s_barrier(); asm volatile("" ::: "memory"); }
DI unsigned xcc_id() { return (unsigned)__builtin_amdgcn_s_getreg((3 << 11) | 20) & 7u; }
DI void gbar(unsigned* bar, unsigned k, unsigned nx, unsigned nxcc, unsigned xcc) {
    asm volatile("s_waitcnt vmcnt(0) lgkmcnt(0)" ::: "memory");
    __builtin_amdgcn_s_barrier();
    if (__builtin_amdgcn_workitem_id_x() == 0) {
        const unsigned old = __hip_atomic_fetch_add(bar + 64 * xcc, 1u, __ATOMIC_RELAXED, __HIP_MEMORY_SCOPE_AGENT);
        if (old + 1u == k * nx) {
            __builtin_amdgcn_fence(__ATOMIC_RELEASE, "agent");
            asm volatile("s_waitcnt vmcnt(0) lgkmcnt(0)" ::: "memory");
            __hip_atomic_fetch_add(bar + 1024, 1u, __ATOMIC_RELAXED, __HIP_MEMORY_SCOPE_AGENT);
            while (__hip_atomic_load(bar + 1024, __ATOMIC_RELAXED, __HIP_MEMORY_SCOPE_AGENT) < k * nxcc) __builtin_amdgcn_s_sleep(1);
            __hip_atomic_store(bar + 1536 + 64 * xcc, k, __ATOMIC_RELAXED, __HIP_MEMORY_SCOPE_AGENT);
        } else {
            while (__hip_atomic_load(bar + 1536 + 64 * xcc, __ATOMIC_RELAXED, __HIP_MEMORY_SCOPE_AGENT) < k) __builtin_amdgcn_s_sleep(1);
        }
        __builtin_amdgcn_fence(__ATOMIC_ACQUIRE, "agent");
        asm volatile("s_waitcnt vmcnt(0)" ::: "memory");
    }
    asm volatile("" ::: "memory");
    __builtin_amdgcn_s_barrier();
    asm volatile("" ::: "memory");
}
DI void subbar(unsigned* cnt, unsigned target) {
    asm volatile("s_waitcnt vmcnt(0) lgkmcnt(0)" ::: "memory");
    __builtin_amdgcn_s_barrier();
    if (__builtin_amdgcn_workitem_id_x() == 0) {
        __builtin_amdgcn_fence(__ATOMIC_RELEASE, "agent");
        asm volatile("s_waitcnt vmcnt(0) lgkmcnt(0)" ::: "memory");
        __hip_atomic_fetch_add(cnt, 1u, __ATOMIC_RELAXED, __HIP_MEMORY_SCOPE_AGENT);
        while (__hip_atomic_load(cnt, __ATOMIC_RELAXED, __HIP_MEMORY_SCOPE_AGENT) < target) __builtin_amdgcn_s_sleep(4);
        __builtin_amdgcn_fence(__ATOMIC_ACQUIRE, "agent");
        asm volatile("s_waitcnt vmcnt(0)" ::: "memory");
    }
    asm volatile("" ::: "memory");
    __builtin_amdgcn_s_barrier();
    asm volatile("" ::: "memory");
}
DI int crow(int reg, int h) { return (reg & 3) + 8 * (reg >> 2) + 4 * h; }
#define MFMA32(a, b, c) __builtin_amdgcn_mfma_f32_32x32x16_bf16((a), (b), (c), 0, 0, 0)

namespace pg8 {
constexpr int BM = 256, BK = 64, HALF = 128, HTB = HALF * BK * 2, STAGE_BYTES = 8 * HTB, NXCD = 8, WGM = 8;
DI int lds_byte(int r, int c) { const int st = (r >> 4) * 2 + (c >> 5), rr = r & 15, cc = c & 31, ob = rr * 64 + cc * 2; return st * 1024 + (ob ^ (((ob >> 9) & 1) << 5)); }
DI void stage_rc(int b, int& R, int& C) { const int st = b / 1024, sb = b % 1024, swz = sb ^ (((sb >> 9) & 1) << 5); R = (st >> 1) * 16 + swz / 64; C = (st & 1) * 32 + (swz % 64) / 2; }
DI int perm32(int rho) { const int n = rho >> 4, i = rho & 15; return 8 * (i >> 2) + 4 * n + (i & 3); }
struct Unit { int pm, pn; };
struct Gemm { const bf16_t* A; const bf16_t* Bt; int lda, ldb, K; };

struct StaticOrder {
    int nM, nN, nwg, G, c;
    DI void init(int M, int N, int G_, int c_) { nM = M / BM; nN = N / BM; nwg = nM * nN; G = G_; c = c_; }
    DI bool next(int i, Unit& u) const {
        const long Li = (long)i * G + c; if (c < 0 || Li >= nwg) return false;
        int wgid = (int)Li; { const int q = nwg / NXCD, r = nwg % NXCD, xcd = wgid % NXCD, off = wgid / NXCD; wgid = (xcd < r ? xcd * (q + 1) : r * (q + 1) + (xcd - r) * q) + off; }
        const int nig = WGM * nN, gid = wgid / nig, fm = gid * WGM, gsz = (nM - fm) < WGM ? (nM - fm) : WGM;
        u.pm = fm + ((wgid % nig) % gsz); u.pn = (wgid % nig) / gsz; return true;
    }
};
struct OrderS5Y { int G, c; DI bool next(int i, Unit& u) const { const int Li = i * G + c; if (c < 0 || Li >= 256) return false; const int g = Li >> 2; u.pm = 2 * g + ((Li >> 1) & 1); u.pn = 2 * g + (Li & 1); return true; } };
struct OrderProj : StaticOrder { int logit; DI bool next(int i, Unit& u) const { if (!logit) return StaticOrder::next(i, u); if (i != 0 || c < 0 || c >= 64) return false; u.pm = c; u.pn = 36; return true; } };
struct OrderS5X { int G, c; DI bool next(int i, Unit& u) const { const int Li = i * G + c; if (c < 0 || Li >= 128) return false; const int g = Li >> 1; u.pm = 2 * g + (Li & 1); u.pn = g; return true; } };

template <class Epi, class Sched>
DI void gemm_phase(LAS unsigned char* lds, const Gemm g, const Sched& S, const Epi& E) {
    const int tid = TID(), wid = __builtin_amdgcn_readfirstlane(tid >> 6), lane = tid & 63, wr = wid >> 2, wc = wid & 3, fr = lane & 15, fq = lane >> 4;
    const int K = g.K, nt = K / BK;
    unsigned voffA[2], voffB[2];
#pragma unroll
    for (int i = 0; i < 2; ++i) { int R, C; stage_rc(tid * 16 + i * 8192, R, C); const int Rb = Epi::PERM ? ((R & ~31) + perm32(R & 31)) : R;
        voffA[i] = (unsigned)(R * g.lda + C) * 2u; voffB[i] = (unsigned)(Rb * g.ldb + C) * 2u; }
    const size_t kstep = (size_t)(BK * 2);
    const size_t hstepA = (size_t)HALF * g.lda * 2, hstepB = (size_t)HALF * g.ldb * 2;
    const size_t tstepA = 2 * hstepA, tstepB = 2 * hstepB;
    const unsigned ldsw = (unsigned)wid * 1024u;
    const int aoff = lds_byte(wr * 64 + fr, fq * 8), boff = lds_byte(wc * 32 + fr, fq * 8);
#define PG8_SA(b, h) (((b) * 2 + (h)) * HTB)
#define PG8_SB(b, h) ((4 + (b) * 2 + (h)) * HTB)
#define PG8_STAGE(bufoff, gbase, voff) do { _Pragma("unroll") for (int _i = 0; _i < 2; ++_i) \
        __builtin_amdgcn_global_load_lds((const unsigned*)((const char*)(gbase) + (voff)[_i]), (LAS unsigned*)(lds + (bufoff) + ldsw + _i * 8192), 16, 0, 0); } while (0)
#define PG8_LDA(dst, b, h) do { _Pragma("unroll") for (int m = 0; m < 4; ++m) _Pragma("unroll") for (int k = 0; k < 2; ++k) dst[m][k] = *(const LAS bf16x8*)(lds + PG8_SA(b, h) + aoff + m * 2048 + k * 1024); } while (0)
#define PG8_LDB(dst, b, h) do { _Pragma("unroll") for (int n = 0; n < 2; ++n) _Pragma("unroll") for (int k = 0; k < 2; ++k) dst[n][k] = *(const LAS bf16x8*)(lds + PG8_SB(b, h) + boff + n * 2048 + k * 1024); } while (0)
#define PG8_MMA(ai, bj, At, Bt) do { __builtin_amdgcn_s_setprio(1); _Pragma("unroll") for (int m = 0; m < 4; ++m) _Pragma("unroll") for (int n = 0; n < 2; ++n) _Pragma("unroll") for (int k = 0; k < 2; ++k) \
        acc[ai][bj][m][n] = __builtin_amdgcn_mfma_f32_16x16x32_bf16(Bt[n][k], At[m][k], acc[ai][bj][m][n], 0, 0, 0); __builtin_amdgcn_s_setprio(0); } while (0)
#define PG8_WAIT_V(n) asm volatile("s_waitcnt vmcnt(" #n ")" ::: "memory")
#define PG8_WAIT_L(n) asm volatile("s_waitcnt lgkmcnt(" #n ")" ::: "memory")
#define PG8_BAR __builtin_amdgcn_s_barrier()
#define PG8_SCHED __builtin_amdgcn_sched_barrier(0)
    Unit cur, nxt; int ui = 0;
    if (!S.next(0, cur)) return;
    f32x4 acc[2][2][4][2];
#pragma unroll
    for (int a = 0; a < 2; ++a)
#pragma unroll
        for (int b = 0; b < 2; ++b)
#pragma unroll
            for (int m = 0; m < 4; ++m)
#pragma unroll
                for (int n = 0; n < 2; ++n) acc[a][b][m][n] = (f32x4){0.f, 0.f, 0.f, 0.f};
    bf16x8 At[4][2], B0[2][2], B1[2][2];
    const char* cA = (const char*)g.A + (size_t)cur.pm * tstepA; const char* cB = (const char*)g.Bt + (size_t)cur.pn * tstepB;
    PG8_STAGE(PG8_SB(0, 0), cB, voffB); PG8_STAGE(PG8_SA(0, 0), cA, voffA); PG8_STAGE(PG8_SB(0, 1), cB + hstepB, voffB); PG8_STAGE(PG8_SA(0, 1), cA + hstepA, voffA);
    if (wr == 1) PG8_BAR;
    PG8_WAIT_V(4); PG8_BAR;
    PG8_STAGE(PG8_SB(1, 0), cB + kstep, voffB); PG8_STAGE(PG8_SA(1, 0), cA + kstep, voffA); PG8_STAGE(PG8_SB(1, 1), cB + hstepB + kstep, voffB);
    PG8_WAIT_V(6); PG8_BAR;
    for (;;) {
        const bool has_next = S.next(ui + 1, nxt);
        const char* nA = has_next ? (const char*)g.A + (size_t)nxt.pm * tstepA : cA; const char* nB = has_next ? (const char*)g.Bt + (size_t)nxt.pn * tstepB : cB;
        for (int t = 0; t < nt; t += 2) {
            const bool last = (t == nt - 2);
            const char* a1 = cA + (size_t)(t + 1) * kstep;
            const char* a2 = last ? nA : cA + (size_t)(t + 2) * kstep; const char* b2 = last ? nB : cB + (size_t)(t + 2) * kstep;
            const char* a3 = a2 + kstep; const char* b3 = b2 + kstep;
            PG8_LDB(B0, 0, 0); PG8_SCHED; PG8_LDA(At, 0, 0); PG8_STAGE(PG8_SA(1, 1), a1 + hstepA, voffA);
            PG8_WAIT_L(8); PG8_BAR; PG8_WAIT_L(0); PG8_MMA(0, 0, At, B0); PG8_BAR; PG8_SCHED;
            PG8_LDB(B1, 0, 1); PG8_STAGE(PG8_SB(0, 0), b2, voffB);
            PG8_BAR; PG8_WAIT_L(0); PG8_MMA(0, 1, At, B1); PG8_BAR;
            PG8_LDA(At, 0, 1); PG8_STAGE(PG8_SA(0, 0), a2, voffA);
            PG8_BAR; PG8_WAIT_L(0); PG8_MMA(1, 0, At, B0); PG8_BAR; PG8_SCHED;
            PG8_STAGE(PG8_SB(0, 1), b2 + hstepB, voffB);
            PG8_WAIT_V(6); PG8_BAR; PG8_MMA(1, 1, At, B1); PG8_BAR;
            PG8_LDB(B0, 1, 0); PG8_SCHED; PG8_LDA(At, 1, 0); PG8_STAGE(PG8_SA(0, 1), a2 + hstepA, voffA);
            PG8_WAIT_L(8); PG8_BAR; PG8_WAIT_L(0); PG8_MMA(0, 0, At, B0); PG8_BAR; PG8_SCHED;
            PG8_LDB(B1, 1, 1); PG8_STAGE(PG8_SB(1, 0), b3, voffB);
            PG8_BAR; PG8_WAIT_L(0); PG8_MMA(0, 1, At, B1); PG8_BAR;
            PG8_LDA(At, 1, 1); PG8_STAGE(PG8_SA(1, 0), a3, voffA);
            PG8_BAR; PG8_WAIT_L(0); PG8_MMA(1, 0, At, B0); PG8_BAR; PG8_SCHED;
            PG8_STAGE(PG8_SB(1, 1), b3 + hstepB, voffB);
            PG8_WAIT_V(6); PG8_BAR; PG8_MMA(1, 1, At, B1); PG8_BAR;
        }
        E(acc, cur, wr, wc, fr, fq);
        if (!has_next) break;
#pragma unroll
        for (int a = 0; a < 2; ++a)
#pragma unroll
            for (int b = 0; b < 2; ++b)
#pragma unroll
                for (int m = 0; m < 4; ++m)
#pragma unroll
                    for (int n = 0; n < 2; ++n) acc[a][b][m][n] = (f32x4){0.f, 0.f, 0.f, 0.f};
        cur = nxt; cA = nA; cB = nB; ++ui;
    }
    PG8_WAIT_V(0);
    if (wr == 0) PG8_BAR;
    PG8_BAR;
#undef PG8_SA
#undef PG8_SB
#undef PG8_STAGE
#undef PG8_LDA
#undef PG8_LDB
#undef PG8_MMA
#undef PG8_WAIT_V
#undef PG8_WAIT_L
#undef PG8_BAR
#undef PG8_SCHED
}

typedef f32x4 Acc[2][2][4][2];
#define EPI_LOOP_PERM(...) _Pragma("unroll") for (int ai = 0; ai < 2; ++ai) _Pragma("unroll") for (int m = 0; m < 4; ++m) { const int row = u.pm * 256 + ai * 128 + wr * 64 + m * 16 + fr; \
    _Pragma("unroll") for (int bj = 0; bj < 2; ++bj) { const int c8 = bj * 128 + wc * 32 + 8 * fq; f32x4 v0 = acc[ai][bj][m][0], v1 = acc[ai][bj][m][1]; __VA_ARGS__ } }

struct EpiProj {
    static constexpr bool PERM = true;
    bf16_t *uperm, *qkv, *z, *sgs, *sgg; float* logit;
    DI void operator()(const Acc& acc, const Unit& u, int wr, int wc, int fr, int fq) const {
        const int pn = u.pn;
        if (pn < 4) {
            EPI_LOOP_PERM({ const int ch = pn * 256 + c8; *(u32x4*)(uperm + ((size_t)((ch >> 4) * 512 + (row >> 5)) * 640 + (row & 31) * 16 + (ch & 15))) = pack44(v0, v1); })
        } else if (pn < 16) {
            EPI_LOOP_PERM({ *(u32x4*)(qkv + (size_t)row * 3072 + (pn - 4) * 256 + c8) = pack44(v0, v1); })
        } else if (pn < 20) {
            EPI_LOOP_PERM({ *(u32x4*)(z + (size_t)row * 1024 + (pn - 16) * 256 + c8) = pack44(v0, v1); })
        } else if (pn < 36) {
            bf16_t* dst = pn < 28 ? sgs + (pn - 20) * 256 : sgg + (pn - 28) * 256;
            EPI_LOOP_PERM({ for (int j = 0; j < 4; ++j) { v0[j] = sigmoidf_(v0[j]); v1[j] = sigmoidf_(v1[j]); } *(u32x4*)(dst + (size_t)row * 2048 + c8) = pack44(v0, v1); })
        } else {
            EPI_LOOP_PERM({ if (bj == 0 && wc == 0 && fq < 2) { *(f32x4*)(logit + (size_t)row * 16 + 8 * fq) = v0; *(f32x4*)(logit + (size_t)row * 16 + 8 * fq + 4) = v1; } })
        }
    }
};
struct EpiXend {
    static constexpr bool PERM = false;
    float* xend;
    DI void operator()(const Acc& acc, const Unit& u, int wr, int wc, int fr, int fq) const {
#pragma unroll
        for (int ai = 0; ai < 2; ++ai)
#pragma unroll
            for (int m = 0; m < 4; ++m) { const int row = u.pm * 256 + ai * 128 + wr * 64 + m * 16 + fr;
#pragma unroll
                for (int n = 0; n < 2; ++n) *(f32x4*)(xend + (size_t)row * 128 + wc * 32 + 16 * n + 4 * fq) = acc[ai][0][m][n]; }
    }
};
struct EpiS5Y {
    static constexpr bool PERM = true;
    const bf16_t* uperm; const float* dskip; bf16_t* zs;
    DI void operator()(const Acc& acc, const Unit& u, int wr, int wc, int fr, int fq) const {
        const int g = u.pm >> 1, mt = u.pm & 1, nt = u.pn & 1, ho0 = 8 * (fq & 1);
        const f32x4 d0 = *(const f32x4*)(dskip + g * 16 + ho0), d1 = *(const f32x4*)(dskip + g * 16 + ho0 + 4);
#pragma unroll
        for (int ai = 0; ai < 2; ++ai)
#pragma unroll
            for (int mp = 0; mp < 2; ++mp) {
                u32x4 uv[2][2];
#pragma unroll
                for (int mi = 0; mi < 2; ++mi)
#pragma unroll
                    for (int bj = 0; bj < 2; ++bj) { const int chunk = mt * 256 + ai * 128 + wr * 64 + (2 * mp + mi) * 16 + fr, n0 = nt * 256 + bj * 128 + wc * 32 + 8 * fq;
                        uv[mi][bj] = *(const u32x4*)(uperm + (size_t)(g * 512 + chunk) * 640 + n0); }
#pragma unroll
                for (int mi = 0; mi < 2; ++mi)
#pragma unroll
                    for (int bj = 0; bj < 2; ++bj) { const int m = 2 * mp + mi, chunk = mt * 256 + ai * 128 + wr * 64 + m * 16 + fr, n0 = nt * 256 + bj * 128 + wc * 32 + 8 * fq, t = n0 >> 4;
                        f32x4 v0 = acc[ai][bj][m][0], v1 = acc[ai][bj][m][1]; float uf[8]; unpack8(uv[mi][bj], uf);
                        for (int j = 0; j < 4; ++j) { v0[j] = gelu_tanh(v0[j] + d0[j] * uf[j]); v1[j] = gelu_tanh(v1[j] + d1[j] * uf[4 + j]); }
                        *(u32x4*)(zs + (size_t)(chunk * 32 + t) * 1024 + g * 16 + ho0) = pack44(v0, v1); }
            }
    }
};
struct EpiGlu {
    static constexpr bool PERM = true;
    const bf16_t* zs; const float* bias; bf16_t* y2;
    DI void operator()(const Acc& acc, const Unit& u, int wr, int wc, int fr, int fq) const {
        f32x4 bv[2][2];
#pragma unroll
        for (int bj = 0; bj < 2; ++bj) { const int col = u.pn * 256 + bj * 128 + wc * 32 + 8 * fq; bv[bj][0] = *(const f32x4*)(bias + col); bv[bj][1] = *(const f32x4*)(bias + col + 4); }
#pragma unroll
        for (int ai = 0; ai < 2; ++ai)
#pragma unroll
            for (int mp = 0; mp < 2; ++mp) {
                u32x4 zv[2][2];
#pragma unroll
                for (int mi = 0; mi < 2; ++mi)
#pragma unroll
                    for (int bj = 0; bj < 2; ++bj) { const int row = u.pm * 256 + ai * 128 + wr * 64 + (2 * mp + mi) * 16 + fr, col = u.pn * 256 + bj * 128 + wc * 32 + 8 * fq;
                        zv[mi][bj] = *(const u32x4*)(zs + (size_t)row * 1024 + col); }
#pragma unroll
                for (int mi = 0; mi < 2; ++mi)
#pragma unroll
                    for (int bj = 0; bj < 2; ++bj) { const int m = 2 * mp + mi, row = u.pm * 256 + ai * 128 + wr * 64 + m * 16 + fr, col = u.pn * 256 + bj * 128 + wc * 32 + 8 * fq;
                        f32x4 v0 = acc[ai][bj][m][0], v1 = acc[ai][bj][m][1]; float zf[8]; unpack8(zv[mi][bj], zf);
                        for (int j = 0; j < 4; ++j) { v0[j] = zf[j] * sigmoidf_(v0[j] + bv[bj][0][j]); v1[j] = zf[4 + j] * sigmoidf_(v1[j] + bv[bj][1][j]); }
                        *(u32x4*)(y2 + (size_t)row * 1024 + col) = pack44(v0, v1); }
            }
    }
};
template <int SECOND> struct EpiUp {
    static constexpr bool PERM = true;
    const bf16_t* gate; const bf16_t* t1in; bf16_t* dst;
    DI void operator()(const Acc& acc, const Unit& u, int wr, int wc, int fr, int fq) const {
#pragma unroll
        for (int ai = 0; ai < 2; ++ai)
#pragma unroll
            for (int mp = 0; mp < 2; ++mp) {
                u32x4 gv[2][2], tv[2][2];
#pragma unroll
                for (int mi = 0; mi < 2; ++mi)
#pragma unroll
                    for (int bj = 0; bj < 2; ++bj) { const size_t o = (size_t)(u.pm * 256 + ai * 128 + wr * 64 + (2 * mp + mi) * 16 + fr) * 2048 + u.pn * 256 + bj * 128 + wc * 32 + 8 * fq;
                        gv[mi][bj] = *(const u32x4*)(gate + o); if (SECOND) tv[mi][bj] = *(const u32x4*)(t1in + o); else tv[mi][bj] = (u32x4){0u, 0u, 0u, 0u}; }
#pragma unroll
                for (int mi = 0; mi < 2; ++mi)
#pragma unroll
                    for (int bj = 0; bj < 2; ++bj) { const int m = 2 * mp + mi; const size_t o = (size_t)(u.pm * 256 + ai * 128 + wr * 64 + m * 16 + fr) * 2048 + u.pn * 256 + bj * 128 + wc * 32 + 8 * fq;
                        f32x4 v0 = acc[ai][bj][m][0], v1 = acc[ai][bj][m][1]; float gf[8], tf[8]; unpack8(gv[mi][bj], gf); unpack8(tv[mi][bj], tf);
                        for (int j = 0; j < 4; ++j) { v0[j] = tf[j] + gf[j] * v0[j]; v1[j] = tf[4 + j] + gf[4 + j] * v1[j]; }
                        *(u32x4*)(dst + o) = pack44(v0, v1); }
            }
    }
};
struct EpiBranch {
    static constexpr bool PERM = true;
    const float* gate; bf16_t* y;
    DI void operator()(const Acc& acc, const Unit& u, int wr, int wc, int fr, int fq) const {
        f32x4 gv[2][2];
#pragma unroll
        for (int bj = 0; bj < 2; ++bj) { const int col = u.pn * 256 + bj * 128 + wc * 32 + 8 * fq; gv[bj][0] = *(const f32x4*)(gate + col); gv[bj][1] = *(const f32x4*)(gate + col + 4); }
        EPI_LOOP_PERM({ *(u32x4*)(y + (size_t)row * 2048 + u.pn * 256 + c8) = pack44(gv[bj][0] * v0, gv[bj][1] * v1); })
    }
};
struct EpiResid {
    static constexpr bool PERM = false;
    const float* xin; const float* gate; float* out;
    DI void operator()(const Acc& acc, const Unit& u, int wr, int wc, int fr, int fq) const {
        f32x4 gv[2][2];
#pragma unroll
        for (int bj = 0; bj < 2; ++bj)
#pragma unroll
            for (int n = 0; n < 2; ++n) gv[bj][n] = *(const f32x4*)(gate + u.pn * 256 + bj * 128 + wc * 32 + 16 * n + 4 * fq);
#pragma unroll
        for (int ai = 0; ai < 2; ++ai)
#pragma unroll
            for (int mp = 0; mp < 2; ++mp) {
                f32x4 xv[2][2][2];
#pragma unroll
                for (int mi = 0; mi < 2; ++mi)
#pragma unroll
                    for (int bj = 0; bj < 2; ++bj)
#pragma unroll
                        for (int n = 0; n < 2; ++n) xv[mi][bj][n] = *(const f32x4*)(xin + (size_t)(u.pm * 256 + ai * 128 + wr * 64 + (2 * mp + mi) * 16 + fr) * 2048 + u.pn * 256 + bj * 128 + wc * 32 + 16 * n + 4 * fq);
#pragma unroll
                for (int mi = 0; mi < 2; ++mi)
#pragma unroll
                    for (int bj = 0; bj < 2; ++bj)
#pragma unroll
                        for (int n = 0; n < 2; ++n) { const int m = 2 * mp + mi;
                            *(f32x4*)(out + (size_t)(u.pm * 256 + ai * 128 + wr * 64 + m * 16 + fr) * 2048 + u.pn * 256 + bj * 128 + wc * 32 + 16 * n + 4 * fq) = ALPHA * xv[mi][bj][n] + gv[bj][n] * acc[ai][bj][m][n]; }
            }
    }
};
struct EpiSwiglu {
    static constexpr bool PERM = true;
    bf16_t* a;
    DI void operator()(const Acc& acc, const Unit& u, int wr, int wc, int fr, int fq) const {
#pragma unroll
        for (int ai = 0; ai < 2; ++ai)
#pragma unroll
            for (int m = 0; m < 4; ++m) { const int row = u.pm * 256 + ai * 128 + wr * 64 + m * 16 + fr;
                f32x4 g0 = acc[ai][0][m][0], g1 = acc[ai][0][m][1]; const f32x4 u0 = acc[ai][1][m][0], u1 = acc[ai][1][m][1];
                for (int j = 0; j < 4; ++j) { g0[j] = siluf_(g0[j]) * u0[j]; g1[j] = siluf_(g1[j]) * u1[j]; }
                *(u32x4*)(a + (size_t)row * FH + u.pn * 128 + wc * 32 + 8 * fq) = pack44(g0, g1); }
    }
};
}

template <int MODE> DI int rowmap(int n) {
    if (MODE == 1) return n < 5120 ? n : (n < 5136 ? 9216 + (n - 5120) : n - 16);
    if (MODE == 2) { if (n < 5632) return (n >> 7) * 256 + (n & 127); const int m = n - 5632; return (m >> 7) * 256 + 128 + (m & 127); }
    return n;
}
template <int MODE> DI void transpose_job(LAS unsigned char* lds, const float* src, int K, int N, bf16_t* dst, int bid, int nblk) {
    const int tid = TID(), tn = (N + 63) >> 6, tk = K >> 6, ntile = tn * tk;
    for (int t0 = bid; t0 < ntile; t0 += 2 * nblk) {
#pragma unroll
        for (int q = 0; q < 2; ++q) { const int t = t0 + q * nblk; LAS float* tl = (LAS float*)(lds + q * 16640);
            if (t < ntile) { const int k0 = (t / tn) * 64, n0 = (t % tn) * 64;
#pragma unroll
                for (int i = 0; i < 2; ++i) { const int kk = (tid >> 4) + 32 * i, nn = (tid & 15) * 4;
                    f32x4 v = {0.f, 0.f, 0.f, 0.f}; if (n0 + nn < N) v = *(const f32x4*)(src + (size_t)(k0 + kk) * N + n0 + nn);
                    tl[kk * 65 + nn] = v[0]; tl[kk * 65 + nn + 1] = v[1]; tl[kk * 65 + nn + 2] = v[2]; tl[kk * 65 + nn + 3] = v[3]; } } }
        lds_barrier();
#pragma unroll
        for (int q = 0; q < 2; ++q) { const int t = t0 + q * nblk; LAS float* tl = (LAS float*)(lds + q * 16640);
            if (t < ntile) { const int k0 = (t / tn) * 64, n0 = (t % tn) * 64, n = tid >> 3, ko = (tid & 7) * 8;
                if (n0 + n < N) { float f[8];
#pragma unroll
                    for (int jq = 0; jq < 8; ++jq) f[jq] = tl[(ko + jq) * 65 + n];
                    *(u32x4*)(dst + (size_t)rowmap<MODE>(n0 + n) * K + k0 + ko) = pack8(f); } } }
        lds_barrier();
    }
}

DI void phase_weights_a(LAS unsigned char* lds, PP p, int l, int bid, int nblk) {
    unsigned char* ws = p->ws;
    transpose_job<1>(lds, p->in[4] + (size_t)l * 2048 * 9232, 2048, 9232, (bf16_t*)(ws + O_WIN), bid, nblk);
    transpose_job<0>(lds, p->in[13] + (size_t)l * 1024 * 1024, 1024, 1024, (bf16_t*)(ws + O_WGLU), bid, nblk);
    transpose_job<0>(lds, p->in[19] + (size_t)l * 1024 * 2048, 1024, 2048, (bf16_t*)(ws + O_WUPS), bid, nblk);
    { u32x4* z = (u32x4*)(ws + O_WIN + (size_t)9232 * 2048 * 2); const int nz = 240 * 2048 * 2 / 16;
      for (int i = bid * NTHR + TID(); i < nz; i += nblk * NTHR) z[i] = (u32x4){0u, 0u, 0u, 0u}; }
}
DI void phase_weights_b(LAS unsigned char* lds, PP p, int l, int bid, int nblk) {
    unsigned char* ws = p->ws;
    transpose_job<0>(lds, p->in[20] + (size_t)l * 1024 * 2048, 1024, 2048, (bf16_t*)(ws + O_WUPG), bid, nblk);
    transpose_job<0>(lds, p->in[21] + (size_t)l * 2048 * 2048, 2048, 2048, (bf16_t*)(ws + O_WOUT), bid, nblk);
    transpose_job<2>(lds, p->in[24] + (size_t)l * 2048 * 11264, 2048, 11264, (bf16_t*)(ws + O_WF1), bid, nblk);
    transpose_job<0>(lds, p->in[25] + (size_t)l * 5632 * 2048, 5632, 2048, (bf16_t*)(ws + O_WF2), bid, nblk);
}

DI void phase_mod(LAS unsigned char* lds, PP p) {
    LAS float* red = (LAS float*)lds;
    const int tid = TID(), col = tid & 31, kp = tid >> 5;
    const float* c = p->in[1];
    float* mod = (float*)(p->ws + O_MOD);
    for (int u = BID(); u < 768; u += GDIM()) {
        const int l = u / 384, c0 = (u % 384) * 32;
        const float* w = p->in[2] + (size_t)l * 2048 * 12288 + c0 + col;
        float s = 0.f;
        for (int k = kp * 128; k < kp * 128 + 128; ++k) { const float cv = c[k]; s += (cv / (1.f + __expf(-cv))) * w[(size_t)k * 12288]; }
        red[kp * 32 + col] = s;
        __syncthreads();
        if (tid < 32) { float t = 0.f; for (int i = 0; i < 16; ++i) t += red[i * 32 + tid]; mod[l * 12288 + c0 + tid] = t + p->in[3][l * 12288 + c0 + tid]; }
        __syncthreads();
    }
}

DI void phase_s5pre(LAS unsigned char* lds, PP p, int l, int bid, int nblk) {
    LAS float* apr = (LAS float*)lds;
    LAS float* api = apr + 33 * 64;
    LAS float* bbr = api + 33 * 64;
    LAS float* bbi = bbr + 1024;
    LAS float* ccr = bbi + 1024;
    LAS float* cci = ccr + 1024;
    LAS float* kt = cci + 1024;
    const int tid = TID();
    bf16_t* bt2 = (bf16_t*)(p->ws + O_BT2); bf16_t* m2 = (bf16_t*)(p->ws + O_M2); float* a32 = (float*)(p->ws + O_A32);
    for (int g = bid; g < 64; g += nblk) {
        const float dt = expf(p->in[7][l * 64 + g]);
        for (int id = tid; id < 33 * 64; id += NTHR) { const int pp = id & 63, j = id >> 6;
            const float lr = p->in[5][(l * 64 + g) * 64 + pp], li = p->in[6][(l * 64 + g) * 64 + pp];
            const float mg = expf(lr * dt * (float)j), an = li * dt * (float)j; float sn, cs; sincosf(an, &sn, &cs); const float re = mg * cs, im = mg * sn;
            apr[j * 64 + pp] = re; api[j * 64 + pp] = im;
            if (j == 32) { a32[(g * 64 + pp) * 2] = re; a32[(g * 64 + pp) * 2 + 1] = im; } }
        for (int id = tid; id < 1024; id += NTHR) { const int pp = id >> 4, hi = id & 15;
            const float lr = p->in[5][(l * 64 + g) * 64 + pp], li = p->in[6][(l * 64 + g) * 64 + pp];
            const float mg = expf(lr * dt), an = li * dt; float sn, cs; sincosf(an, &sn, &cs); const float nr = mg * cs - 1.0f, ni = mg * sn, den = lr * lr + li * li;
            const float fr = (nr * lr + ni * li) / den, fi = (ni * lr - nr * li) / den;
            const size_t bo = ((size_t)(l * 64 + g) * 64 + pp) * 16 + hi; const float br = p->in[8][bo], bi = p->in[9][bo];
            bbr[id] = fr * br - fi * bi; bbi[id] = fr * bi + fi * br;
            const int ho = id >> 6, p2 = id & 63; const size_t co = ((size_t)(l * 64 + g) * 16 + ho) * 64 + p2;
            ccr[id] = p->in[10][co]; cci[id] = p->in[11][co]; }
        __syncthreads();
        for (int id = tid; id < 32 * 256; id += NTHR) { const int j = id >> 8, ho = (id >> 4) & 15, hi = id & 15; float s = 0.f;
            for (int pp = 0; pp < 64; ++pp) { const float ar = apr[j * 64 + pp], ai = api[j * 64 + pp], br = bbr[pp * 16 + hi], bi = bbi[pp * 16 + hi];
                const float wr_ = ar * br - ai * bi, wi_ = ar * bi + ai * br; s += ccr[ho * 64 + pp] * wr_ - cci[ho * 64 + pp] * wi_; }
            kt[id] = s; }
        __syncthreads();
        for (int id = tid; id < 512 * 80; id += NTHR) { const int n = id / 80, oc = id % 80, t = n >> 4, ho = n & 15; float f[8];
            if (oc < 64) { const int s = oc >> 1, hi0 = (oc & 1) * 8;
                for (int i = 0; i < 8; ++i) f[i] = (s <= t) ? kt[(t - s) * 256 + ho * 16 + hi0 + i] : 0.f;
            } else { for (int i = 0; i < 8; ++i) { const int cc = (oc - 64) * 8 + i, ri = cc >> 6, pp = cc & 63;
                const float ar = apr[(t + 1) * 64 + pp], ai = api[(t + 1) * 64 + pp], cr = ccr[ho * 64 + pp], ci = cci[ho * 64 + pp];
                f[i] = ri == 0 ? (cr * ar - ci * ai) : -(cr * ai + ci * ar); } }
            *(u32x4*)(bt2 + ((size_t)g * 512 + n) * 640 + oc * 8) = pack8(f); }
        for (int id = tid; id < 256 * 64; id += NTHR) { const int rr = id >> 6, oc = id & 63; float f[8];
            if (rr < 128) { const int ri = rr >> 6, pp = rr & 63, s = oc >> 1, hi0 = (oc & 1) * 8; const float ar = apr[(31 - s) * 64 + pp], ai = api[(31 - s) * 64 + pp];
                for (int i = 0; i < 8; ++i) { const float br = bbr[pp * 16 + hi0 + i], bi = bbi[pp * 16 + hi0 + i]; f[i] = ri == 0 ? (ar * br - ai * bi) : (ar * bi + ai * br); }
            } else { for (int i = 0; i < 8; ++i) f[i] = 0.f; }
            *(u32x4*)(m2 + ((size_t)g * 256 + rr) * 512 + oc * 8) = pack8(f); }
        __syncthreads();
    }
}

DI float wave_sum(float v) {
#pragma unroll
    for (int o = 32; o >= 1; o >>= 1) v += __shfl_xor(v, o);
    return v;
}
template <bool FIRST, bool SECOND, bool BR = false>
DI void phase_ln(const float* src, const float* g, const float* b, float* dst1, const float* sh, const float* sc, bf16_t* dsth, const bf16_t* ybr = nullptr) {
    const int wid = TID() >> 6, lane = TID() & 63;
    for (int row0 = (BID() * 8 + wid) * 2; row0 < L; row0 += GDIM() * 16) {
        float v[2][4][8];
#pragma unroll
        for (int rr = 0; rr < 2; ++rr)
#pragma unroll
            for (int i = 0; i < 4; ++i) { const float* sp = src + (size_t)(row0 + rr) * DM + i * 512 + lane * 8; const f32x4 a = *(const f32x4*)sp, c = *(const f32x4*)(sp + 4);
                v[rr][i][0] = a[0]; v[rr][i][1] = a[1]; v[rr][i][2] = a[2]; v[rr][i][3] = a[3]; v[rr][i][4] = c[0]; v[rr][i][5] = c[1]; v[rr][i][6] = c[2]; v[rr][i][7] = c[3]; }
        if (BR) {
#pragma unroll
            for (int rr = 0; rr < 2; ++rr)
#pragma unroll
                for (int i = 0; i < 4; ++i) { float yf[8]; unpack8(*(const u32x4*)(ybr + (size_t)(row0 + rr) * DM + i * 512 + lane * 8), yf);
                    for (int k = 0; k < 8; ++k) v[rr][i][k] = ALPHA * v[rr][i][k] + yf[k]; }
        }
        if (FIRST) {
            f32x4 P0[4][2], P1[4][2];
#pragma unroll
            for (int i = 0; i < 4; ++i) { const int c0 = i * 512 + lane * 8; P0[i][0] = *(const f32x4*)(g + c0); P0[i][1] = *(const f32x4*)(g + c0 + 4); P1[i][0] = *(const f32x4*)(b + c0); P1[i][1] = *(const f32x4*)(b + c0 + 4); }
#pragma unroll
            for (int rr = 0; rr < 2; ++rr) {
                float s = 0.f;
#pragma unroll
                for (int i = 0; i < 4; ++i) for (int k = 0; k < 8; ++k) s += v[rr][i][k];
                const float mu = wave_sum(s) * (1.f / DM); float q = 0.f;
#pragma unroll
                for (int i = 0; i < 4; ++i) for (int k = 0; k < 8; ++k) { const float d = v[rr][i][k] - mu; q += d * d; }
                const float rs = rsqrtf(wave_sum(q) * (1.f / DM) + 1e-5f);
#pragma unroll
                for (int i = 0; i < 4; ++i) { const int c0 = i * 512 + lane * 8;
                    for (int k = 0; k < 8; ++k) v[rr][i][k] = (v[rr][i][k] - mu) * rs * P0[i][k >> 2][k & 3] + P1[i][k >> 2][k & 3];
                    *(f32x4*)(dst1 + (size_t)(row0 + rr) * DM + c0) = (f32x4){v[rr][i][0], v[rr][i][1], v[rr][i][2], v[rr][i][3]};
                    *(f32x4*)(dst1 + (size_t)(row0 + rr) * DM + c0 + 4) = (f32x4){v[rr][i][4], v[rr][i][5], v[rr][i][6], v[rr][i][7]}; }
            }
        }
        if (SECOND) {
            f32x4 P0[4][2], P1[4][2];
#pragma unroll
            for (int i = 0; i < 4; ++i) { const int c0 = i * 512 + lane * 8; P0[i][0] = *(const f32x4*)(sc + c0); P0[i][1] = *(const f32x4*)(sc + c0 + 4); P1[i][0] = *(const f32x4*)(sh + c0); P1[i][1] = *(const f32x4*)(sh + c0 + 4); }
#pragma unroll
            for (int rr = 0; rr < 2; ++rr) {
                float s = 0.f;
#pragma unroll
                for (int i = 0; i < 4; ++i) for (int k = 0; k < 8; ++k) s += v[rr][i][k];
                const float mu = wave_sum(s) * (1.f / DM); float q = 0.f;
#pragma unroll
                for (int i = 0; i < 4; ++i) for (int k = 0; k < 8; ++k) { const float d = v[rr][i][k] - mu; q += d * d; }
                const float rs = rsqrtf(wave_sum(q) * (1.f / DM) + 1e-5f);
#pragma unroll
                for (int i = 0; i < 4; ++i) { const int c0 = i * 512 + lane * 8; float f[8];
                    for (int k = 0; k < 8; ++k) f[k] = (v[rr][i][k] - mu) * rs * (1.f + P0[i][k >> 2][k & 3]) + P1[i][k >> 2][k & 3];
                    *(u32x4*)(dsth + (size_t)(row0 + rr) * DM + c0) = pack8(f); }
            }
        }
    }
}

DI void phase_carry(PP p, int bid) {
    const int id = bid * NTHR + TID();
    if (id >= 4096) return;
    const int g = id >> 6, pp = id & 63;
    const float* a32 = (const float*)(p->ws + O_A32); const float* xe = (const float*)(p->ws + O_XEND) + (size_t)g * 512 * 128 + pp;
    bf16_t* up = (bf16_t*)(p->ws + O_E) + (size_t)g * 512 * 640 + 512 + pp;
    const float ar = a32[id * 2], ai = a32[id * 2 + 1];
    float xr = 0.f, xi = 0.f;
#pragma unroll 32
    for (int c = 0; c < 512; ++c) {
        up[(size_t)c * 640] = f2bf(xr); up[(size_t)c * 640 + 64] = f2bf(xi);
        const float er = xe[(size_t)c * 128], ei = xe[(size_t)c * 128 + 64];
        const float nr = ar * xr - ai * xi + er, ni = ar * xi + ai * xr + ei; xr = nr; xi = ni;
    }
}

constexpr int QN_O = 0, KN_O = 17408, XTK_O = 34816, XTV_O = 53248, KT2_O = 71680, TIMG_O = 90112, MM_O = 99328, AT_O = 116736, SC_O = 134144;
DI int xsw(int row, int col) { return row * 72 + ((((col >> 3) ^ (row >> 3)) & 7) << 3) + (col & 7); }
constexpr int CW_O = SC_O + 1024;
DI void gdn_intra(LAS unsigned char* lds, PP p, int l, int first, int stride) {
    { unsigned lb = (unsigned)(size_t)lds; asm volatile("" : "+v"(lb)); lds = (LAS unsigned char*)lb; }
    const float* logit = (const float*)(p->ws + O_LOG); const float* logit2 = (const float*)(p->ws + O_LOG2);
    const bf16_t* qkv = (const bf16_t*)(p->ws + O_QKV);
    const float* cw = p->in[15] + (size_t)l * 4 * 3072;
    float Wp[3]; float LG0 = 0.f, LG1 = 0.f; u32x4 R[24];
#define INTRA_LOADRAW(item_) do { const int hd_ = (item_) >> 8, t0_ = ((item_) & 255) * 64; \
        _Pragma("unroll") for (int mat = 0; mat < 3; ++mat) _Pragma("unroll") for (int it = 0; it < 2; ++it) _Pragma("unroll") for (int kk = 0; kk < 4; ++kk) { \
            const int id = tid + NTHR * it, j = id >> 4, o = id & 15; int t = t0_ + j - 3 + kk; t = t < 0 ? 0 : t; \
            R[(mat * 2 + it) * 4 + kk] = *(const u32x4*)(qkv + (size_t)t * 3072 + mat * 1024 + hd_ * 128 + o * 8); } } while (0)
#define INTRA_PREFETCH(item_) do { const int hd_ = (item_) >> 8, t0_ = ((item_) & 255) * 64; \
        _Pragma("unroll") for (int e = 0; e < 3; ++e) { const int idx = tid + NTHR * e, kk = idx / 384, c = idx - kk * 384; Wp[e] = cw[kk * 3072 + (c >> 7) * 1024 + hd_ * 128 + (c & 127)]; } \
        if (tid < 64) { const size_t lo_ = (size_t)(t0_ + tid) * 16 + hd_; LG0 = logit[lo_] + logit2[lo_]; LG1 = logit[lo_ + 8] + logit2[lo_ + 8]; } } while (0)
    if (first < 2048) { const int tid = TID(); INTRA_PREFETCH(first); INTRA_LOADRAW(first); }
    for (int item = first; item < 2048; item += stride) {
    const int tid = TID(), w = tid >> 6, lane = tid & 63, r = lane & 31, h = lane >> 5;
    { unsigned lb = (unsigned)(size_t)lds; asm volatile("" : "+v"(lb)); lds = (LAS unsigned char*)lb; }
    LAS bf16_t* Qn = (LAS bf16_t*)(lds + QN_O); LAS bf16_t* Kn = (LAS bf16_t*)(lds + KN_O);
    LAS bf16_t* XTk = (LAS bf16_t*)(lds + XTK_O); LAS bf16_t* XTv = (LAS bf16_t*)(lds + XTV_O); LAS bf16_t* KT2 = (LAS bf16_t*)(lds + KT2_O);
    LAS bf16_t* Timg = (LAS bf16_t*)(lds + TIMG_O); LAS float* Mm = (LAS float*)(lds + MM_O); LAS float* At = (LAS float*)(lds + AT_O);
    LAS float* scb = (LAS float*)(lds + SC_O); LAS float* scg = scb + 64; LAS float* sce = scb + 128; LAS float* scl = scb + 192;
    LAS float* CW = (LAS float*)(lds + CW_O);
    const int hd = item >> 8, n = item & 255, tok0 = n * 64;
    unsigned char* fb = p->ws + O_A + (size_t)item * FRAG_ITEM;
    unsigned char* ub = p->ws + O_UFR + (size_t)item * UFR_ITEM;
#pragma unroll
    for (int e = 0; e < 3; ++e) CW[tid + NTHR * e] = Wp[e];
    if (tid < 64) {
        const float bl = LG0, al = LG1;
        const float beta = 1.f / (1.f + __expf(-bl));
        const float xx = al + p->in[17][l * 8 + hd];
        const float ex = __expf(fminf(xx, 20.f));
        const float sp = xx > 20.f ? xx : (ex < 0.05f ? ex * (1.f - ex * (0.5f - ex * (0.33333333f - ex * 0.25f))) : __logf(1.f + ex));
        float gc = -__expf(p->in[16][l * 8 + hd]) * sp;
#pragma unroll
        for (int off = 1; off < 64; off <<= 1) { const float t = __shfl_up(gc, off); if (tid >= off) gc += t; }
        const float gl = __shfl(gc, 63);
        scb[tid] = beta; scg[tid] = gc; sce[tid] = __expf(gc); scl[tid] = __expf(gl - gc);
        if (tid == 0) ((float*)(p->ws + O_GL))[hd * 256 + n] = __expf(gl);
    }
    lds_barrier();
#pragma unroll
    for (int mat = 0; mat < 3; ++mat) {
#pragma unroll
        for (int it = 0; it < 2; ++it) {
            const int id = tid + NTHR * it, j = id >> 4, o = id & 15;
            float a[8];
#pragma unroll
            for (int i = 0; i < 8; ++i) a[i] = 0.f;
#pragma unroll
            for (int kk = 0; kk < 4; ++kk) { const bool ok = tok0 + j - 3 + kk >= 0;
                float x[8]; unpack8(R[(mat * 2 + it) * 4 + kk], x);
                const f32x4 w0 = *(const LAS f32x4*)(CW + kk * 384 + mat * 128 + o * 8), w1 = *(const LAS f32x4*)(CW + kk * 384 + mat * 128 + o * 8 + 4);
                for (int i = 0; i < 4; ++i) { a[i] += ok ? w0[i] * x[i] : 0.f; a[4 + i] += ok ? w1[i] * x[4 + i] : 0.f; } }
#pragma unroll
            for (int i = 0; i < 8; ++i) a[i] = a[i] / (1.f + __expf(-a[i]));
            if (mat < 2) {
                float ss = 0.f;
#pragma unroll
                for (int i = 0; i < 8; ++i) ss += a[i] * a[i];
                ss += __shfl_xor(ss, 1); ss += __shfl_xor(ss, 2); ss += __shfl_xor(ss, 4); ss += __shfl_xor(ss, 8);
                const float sc = rsqrtf(ss + 1e-6f) * (mat == 0 ? 0.08838834764831845f : 1.f);
#pragma unroll
                for (int i = 0; i < 8; ++i) a[i] *= sc;
            }
            if (mat == 0) {
                *(LAS u32x4*)(Qn + j * 136 + o * 8) = pack8(a);
                const float eg = sce[j]; const int ct = j >> 5, s = o >> 1, part = o & 1;
                unsigned char* q0 = fb + 16384 + ((size_t)((ct * 8 + s) * 64 + (j & 31))) * 16 + 8 * part;
                u32x2 lo, hi2; lo.x = pk2(a[0] * eg, a[1] * eg); lo.y = pk2(a[2] * eg, a[3] * eg); hi2.x = pk2(a[4] * eg, a[5] * eg); hi2.y = pk2(a[6] * eg, a[7] * eg);
                *(u32x2*)q0 = lo; *(u32x2*)(q0 + 32 * 16) = hi2;
            } else if (mat == 1) {
                *(LAS u32x4*)(Kn + j * 136 + o * 8) = pack8(a);
                const float f1 = scb[j] * sce[j], f2 = scl[j];
#pragma unroll
                for (int i = 0; i < 8; ++i) { XTk[xsw(o * 8 + i, j)] = f2bf(a[i] * f1); KT2[xsw(o * 8 + i, j)] = f2bf(a[i] * f2); }
            } else {
                const float f1 = scb[j];
#pragma unroll
                for (int i = 0; i < 8; ++i) XTv[xsw(o * 8 + i, j)] = f2bf(a[i] * f1);
            }
            __builtin_amdgcn_sched_barrier(0);
        }
    }
    { const int nxt = item + stride; if (nxt < 2048) { INTRA_PREFETCH(nxt); INTRA_LOADRAW(nxt); } }
    lds_barrier();
    {
        const int isq = w >> 2, it = (w & 3) >> 1, jt = w & 1;
        LAS bf16_t* Ai = isq ? Qn : Kn;
        f32x16 acc; for (int i = 0; i < 16; ++i) acc[i] = 0.f;
#pragma unroll
        for (int s = 0; s < 8; ++s) { const bf16x8 a = *(const LAS bf16x8*)(Ai + (32 * it + r) * 136 + 16 * s + 8 * h), b = *(const LAS bf16x8*)(Kn + (32 * jt + r) * 136 + 16 * s + 8 * h);
            acc = MFMA32(a, b, acc); }
        const int col = 32 * jt + r; const float gcc = scg[col];
#pragma unroll
        for (int i = 0; i < 16; ++i) { const int row = 32 * it + crow(i, h);
            if (isq) At[row * 68 + col] = (row >= col) ? acc[i] * __expf(scg[row] - gcc) : 0.f;
            else Mm[row * 68 + col] = (row > col) ? scb[row] * acc[i] * __expf(scg[row] - gcc) : 0.f; }
    }
    lds_barrier();
    LAS float* T22f = (LAS float*)(lds + QN_O);
    if (w < 2) {
        float t[32];
        const int base = 32 * w; const float cf = (float)r;
#pragma unroll
        for (int i = 0; i < 32; ++i) {
            float a0 = fmaxf(0.f, 1.f - fabsf(cf - (float)i)), a1 = 0.f;
#pragma unroll
            for (int j4 = 0; j4 < (i + 3) / 4; ++j4) { const f32x4 mv = *(const LAS f32x4*)(Mm + (base + i) * 68 + base + j4 * 4);
#pragma unroll
                for (int jj = 0; jj < 4; ++jj) { const int j = j4 * 4 + jj; if (j < i) { if (jj & 1) a1 -= mv[jj] * t[j]; else a0 -= mv[jj] * t[j]; } } }
            t[i] = a0 + a1;
            asm volatile("" : "+v"(t[i]) :: "memory");
        }
#pragma unroll
        for (int i = 0; i < 32; ++i) {
            if (h == 0) Timg[(base + i) * 72 + base + r] = f2bf(t[i]);
            else if (w == 1) Timg[i * 72 + 32 + r] = 0;
            if (w == 1 && h == 0) T22f[i * 33 + r] = t[i];
        }
        lds_barrier();
        if (w == 0) {
            unsigned hmask = h ? 0xffffffffu : 0u; asm volatile("" : "+v"(hmask));
            f32x16 X; for (int i = 0; i < 16; ++i) X[i] = 0.f;
#pragma unroll
            for (int m = 0; m < 16; ++m) { const float a = Mm[(32 + r) * 68 + 2 * m + h]; const float b = __uint_as_float((__float_as_uint(t[2 * m]) & ~hmask) | (__float_as_uint(t[2 * m + 1]) & hmask));
                X = __builtin_amdgcn_mfma_f32_32x32x2f32(a, b, X, 0, 0, 0); }
            f32x16 Y; for (int i = 0; i < 16; ++i) Y[i] = 0.f;
#pragma unroll
            for (int m = 0; m < 16; ++m) { const float a = T22f[r * 33 + crow(m, h)];
                Y = __builtin_amdgcn_mfma_f32_32x32x2f32(a, X[m], Y, 0, 0, 0); }
#pragma unroll
            for (int i = 0; i < 16; ++i) Timg[(32 + crow(i, h)) * 72 + r] = f2bf(-Y[i]);
        }
    } else {
        for (int id = tid - 128; id < 1536; id += 384) {
            const int ln = id & 63, rr = ln & 31, hh = ln >> 5;
            if (id < 1024) { const int f = id >> 6, dt = f >> 2, s = f & 3; const int d = 32 * dt + rr;
                const u32x2 lo = *(const LAS u32x2*)(KT2 + xsw(d, 16 * s + 4 * hh)), hi2 = *(const LAS u32x2*)(KT2 + xsw(d, 16 * s + 8 + 4 * hh));
                *(u32x4*)(fb + 40960 + (size_t)(f * 64 + ln) * 16) = (u32x4){lo.x, lo.y, hi2.x, hi2.y};
            } else { const int f = (id - 1024) >> 6, ct = f >> 2, s = f & 3; const int row = 32 * ct + rr;
                const f32x4 lo = *(const LAS f32x4*)(At + row * 68 + 16 * s + 4 * hh), hi2 = *(const LAS f32x4*)(At + row * 68 + 16 * s + 8 + 4 * hh);
                *(u32x4*)(fb + 32768 + (size_t)(f * 64 + ln) * 16) = pack44(lo, hi2); }
        }
        lds_barrier();
    }
    lds_barrier();
    {
        const int ct = w >> 2, et = w & 3;
        f32x16 acc; for (int i = 0; i < 16; ++i) acc[i] = 0.f;
#pragma unroll
        for (int s = 0; s < 4; ++s) { const bf16x8 a = *(const LAS bf16x8*)(Timg + (32 * ct + r) * 72 + 16 * s + 8 * h), b = *(const LAS bf16x8*)(XTv + xsw(32 * et + r, 16 * s + 8 * h));
            acc = MFMA32(a, b, acc); }
        unsigned char* ud = ub + (size_t)(ct * 4 + et) * 4096 + lane * 16;
#pragma unroll
        for (int q = 0; q < 4; ++q) *(f32x4*)(ud + q * 1024) = (f32x4){acc[4 * q], acc[4 * q + 1], acc[4 * q + 2], acc[4 * q + 3]};
        const int dt = w >> 1, c2 = w & 1;
        f32x16 ac2; for (int i = 0; i < 16; ++i) ac2[i] = 0.f;
#pragma unroll
        for (int s = 0; s < 4; ++s) { const bf16x8 a = *(const LAS bf16x8*)(XTk + xsw(32 * dt + r, 16 * s + 8 * h)), b = *(const LAS bf16x8*)(Timg + (32 * c2 + r) * 72 + 16 * s + 8 * h);
            ac2 = MFMA32(a, b, ac2); }
#pragma unroll
        for (int sp = 0; sp < 2; ++sp) { u32x4 wv; wv.x = pk2(ac2[8 * sp], ac2[8 * sp + 1]); wv.y = pk2(ac2[8 * sp + 2], ac2[8 * sp + 3]); wv.z = pk2(ac2[8 * sp + 4], ac2[8 * sp + 5]); wv.w = pk2(ac2[8 * sp + 6], ac2[8 * sp + 7]);
            *(u32x4*)(fb + (size_t)((c2 * 8 + 2 * dt + sp) * 64 + lane) * 16) = wv; }
    }
    lds_barrier();
    }
#undef INTRA_PREFETCH
#undef INTRA_LOADRAW
}

DI void gdn_scan(LAS unsigned char* lds, PP p, int wg) {
    const int tid = TID(), w = tid >> 6, lane = tid & 63, r = lane & 31, h = lane >> 5;
    const int hd = wg >> 2, cb = wg & 3, rt = w & 3; const bool act = w < 4;
    LAS u32x4* Simg = (LAS u32x4*)lds;
    LAS u32x4* Vimg = (LAS u32x4*)(lds + 8192);
    LAS bf16_t* Oimg = (LAS bf16_t*)(lds + 12288);
    f32x16 S; for (int i = 0; i < 16; ++i) S[i] = 0.f;
    if (act) { Simg[(2 * rt) * 64 + lane] = (u32x4){0u, 0u, 0u, 0u}; Simg[(2 * rt + 1) * 64 + lane] = (u32x4){0u, 0u, 0u, 0u}; }
    lds_barrier();
    const unsigned char* fb = p->ws + O_A + (size_t)(hd * 256) * FRAG_ITEM;
    const unsigned char* ub = p->ws + O_UFR + (size_t)(hd * 256) * UFR_ITEM;
    const float* GL = (const float*)(p->ws + O_GL) + hd * 256;
    bf16_t* obf = (bf16_t*)(p->ws + O_OBF);
    const size_t a1off = (rt < 2 ? 0 : 16384) + (size_t)((rt & 1) * 8) * 1024 + lane * 16;
    const size_t ktoff = 40960 + (size_t)(rt * 4) * 1024 + lane * 16;
    const unsigned char* xbase = rt >= 2 ? fb + 32768 + (size_t)((rt & 1) * 4) * 1024 + lane * 16 : ub + (size_t)((rt & 1) * 4 + cb) * 4096 + lane * 16;
    const size_t xitem = rt >= 2 ? FRAG_ITEM : UFR_ITEM;
#define GLD16(dst, ptr) asm volatile("global_load_dwordx4 %0, %1, off" : "=v"(dst) : "v"(ptr) : "memory")
#define TIE8(NSTR, a, b) asm volatile("s_waitcnt vmcnt(" NSTR ")" : "+v"(a[0]), "+v"(a[1]), "+v"(a[2]), "+v"(a[3]), "+v"(b[0]), "+v"(b[1]), "+v"(b[2]), "+v"(b[3]) :: "memory")
#define SCAN_WAIT_A1(A1_) do { if (rt >= 2) { TIE8("28", A1_, (A1_ + 4)); } else { TIE8("24", A1_, (A1_ + 4)); } } while (0)
#define SCAN_WAIT_X(KT_, X_) do { if (rt >= 2) { TIE8("28", KT_, X_); } else { TIE8("24", KT_, X_); } } while (0)
#define SCAN_LOAD_A1(A1_, n_) do { const unsigned char* f_ = fb + (size_t)(n_) * FRAG_ITEM + a1off; \
        _Pragma("unroll") for (int s = 0; s < 8; ++s) GLD16(A1_[s], f_ + s * 1024); } while (0)
#define SCAN_LOAD_X(KT_, X_, n_) do { const unsigned char* f_ = fb + (size_t)(n_) * FRAG_ITEM + ktoff; const unsigned char* x_ = xbase + (size_t)(n_) * xitem; \
        _Pragma("unroll") for (int s = 0; s < 4; ++s) GLD16(KT_[s], f_ + s * 1024); \
        _Pragma("unroll") for (int s = 0; s < 4; ++s) GLD16(X_[s], x_ + s * 1024); } while (0)
#define SCAN_STEP(n_, A1_, KT_, X_) do { \
        const int nq_ = (n_); const float gsel_ = nq_ < 64 ? glr0 : (nq_ < 128 ? glr1 : (nq_ < 192 ? glr2 : glr3)); \
        const float gl = __int_as_float(__builtin_amdgcn_readlane(__float_as_int(gsel_), nq_ & 63)); const int n2_ = (n_) + 2 < 256 ? (n_) + 2 : 255; \
        f32x16 acc; for (int i = 0; i < 16; ++i) acc[i] = 0.f; \
        if (act) { \
            SCAN_WAIT_A1(A1_); \
            _Pragma("unroll") for (int s = 0; s < 8; ++s) { const bf16x8 b = __builtin_bit_cast(bf16x8, Simg[s * 64 + lane]); acc = MFMA32(__builtin_bit_cast(bf16x8, A1_[s]), b, acc); } \
            asm volatile("" : "+v"(acc)); \
            SCAN_LOAD_A1(A1_, n2_); \
            SCAN_WAIT_X(KT_, X_); \
            if (rt < 2) { \
                _Pragma("unroll") for (int sp = 0; sp < 2; ++sp) { float v[8]; \
                    _Pragma("unroll") for (int j = 0; j < 8; ++j) v[j] = __builtin_bit_cast(f32x4, X_[(8 * sp + j) >> 2])[(8 * sp + j) & 3] - acc[8 * sp + j]; \
                    Vimg[(2 * rt + sp) * 64 + lane] = pack8(v); } } } \
        lds_barrier(); \
        if (act) { \
            _Pragma("unroll") for (int i = 0; i < 16; ++i) S[i] *= gl; \
            _Pragma("unroll") for (int s = 0; s < 4; ++s) { const bf16x8 b = __builtin_bit_cast(bf16x8, Vimg[s * 64 + lane]); S = MFMA32(__builtin_bit_cast(bf16x8, KT_[s]), b, S); \
                if (rt >= 2) acc = MFMA32(__builtin_bit_cast(bf16x8, X_[s]), b, acc); } \
            asm volatile("" : "+v"(acc), "+v"(S)); \
            SCAN_LOAD_X(KT_, X_, n2_); \
            if (rt >= 2) { LAS bf16_t* oi_ = Oimg + (rt - 2) * 1280;     \
                _Pragma("unroll") for (int i = 0; i < 16; ++i) oi_[crow(i, h) * 40 + r] = f2bf(acc[i]); \
                _Pragma("unroll") for (int q = 0; q < 2; ++q) { const int pc = lane + 64 * q, row = pc >> 2, ch = pc & 3; \
                    const u32x4 ov = *(const LAS u32x4*)(oi_ + row * 40 + ch * 8); \
                    *(u32x4*)(obf + (size_t)(64 * (n_) + 32 * (rt - 2) + row) * 1024 + hd * 128 + 32 * cb + ch * 8) = ov; } } \
            _Pragma("unroll") for (int sp = 0; sp < 2; ++sp) { float v[8]; \
                _Pragma("unroll") for (int j = 0; j < 8; ++j) v[j] = S[8 * sp + j]; \
                Simg[(2 * rt + sp) * 64 + lane] = pack8(v); } } \
        lds_barrier(); } while (0)
    u32x4 A1a[8], A1b[8], KTa[4], KTb[4], Xa[4], Xb[4];
    const float glr0 = GL[lane], glr1 = GL[64 + lane], glr2 = GL[128 + lane], glr3 = GL[192 + lane];
    asm volatile("s_waitcnt vmcnt(0)" ::: "memory");
    SCAN_LOAD_A1(A1a, 0); SCAN_LOAD_X(KTa, Xa, 0); SCAN_LOAD_A1(A1b, 1); SCAN_LOAD_X(KTb, Xb, 1);
    TIE8("0", A1a, (A1a + 4)); TIE8("0", KTa, Xa); TIE8("0", A1b, (A1b + 4)); TIE8("0", KTb, Xb);
    for (int n = 0; n < 256; n += 2) {
        SCAN_STEP(n, A1a, KTa, Xa);
        SCAN_STEP(n + 1, A1b, KTb, Xb);
    }
    asm volatile("s_waitcnt vmcnt(0)" ::: "memory");
#undef GLD16
#undef TIE8
#undef SCAN_WAIT_A1
#undef SCAN_WAIT_X
#undef SCAN_LOAD_A1
#undef SCAN_LOAD_X
#undef SCAN_STEP
}

DI void phase_normgate(PP p, int l, int nblk, int bid) {
    bf16_t* obf = (bf16_t*)(p->ws + O_OBF); const bf16_t* z = (const bf16_t*)(p->ws + O_Z);
    const int o8 = TID() & 15;
    const f32x4 w0 = *(const f32x4*)(p->in[18] + l * 128 + o8 * 8), w1 = *(const f32x4*)(p->in[18] + l * 128 + o8 * 8 + 4);
    for (int grp0 = bid * 128 + (TID() >> 4); grp0 < L * 8; grp0 += nblk * 128) {
        u32x4 ov[4], zv[4];
#pragma unroll
        for (int q = 0; q < 4; ++q) { const int grp = grp0 + 32 * q; const size_t base = (size_t)(grp >> 3) * 1024 + (grp & 7) * 128 + o8 * 8;
            ov[q] = *(const u32x4*)(obf + base); zv[q] = *(const u32x4*)(z + base); }
#pragma unroll
        for (int q = 0; q < 4; ++q) { const int grp = grp0 + 32 * q; const size_t base = (size_t)(grp >> 3) * 1024 + (grp & 7) * 128 + o8 * 8;
            float o[8], zz[8]; unpack8(ov[q], o); unpack8(zv[q], zz);
            float ss = 0.f;
#pragma unroll
            for (int i = 0; i < 8; ++i) ss += o[i] * o[i];
            ss += __shfl_xor(ss, 1); ss += __shfl_xor(ss, 2); ss += __shfl_xor(ss, 4); ss += __shfl_xor(ss, 8);
            const float sc = rsqrtf(ss * (1.f / 128.f) + 1e-6f);
#pragma unroll
            for (int i = 0; i < 4; ++i) { o[i] = o[i] * sc * w0[i] * siluf_(zz[i]); o[4 + i] = o[4 + i] * sc * w1[i] * siluf_(zz[4 + i]); }
            *(u32x4*)(obf + base) = pack8(o); }
    }
}

__global__ void __launch_bounds__(512, 2) hybrid_fwd(Params p_arg) {
    extern __shared__ __attribute__((aligned(16))) unsigned char shm[];
    LAS unsigned char* lds = (LAS unsigned char*)shm;
    cg::grid_group grid = cg::this_grid();
    using namespace pg8;
    const unsigned my_xcc = xcc_id();
    if (__builtin_amdgcn_workitem_id_x() == 0) __hip_atomic_fetch_add((unsigned*)(p_arg.ws + O_BAR) + 512 + 64 * my_xcc, 1u, __ATOMIC_RELAXED, __HIP_MEMORY_SCOPE_AGENT);
    unsigned nx_mine = 0, nxcc_act = 0;
    for (int st = 0; st < 24; ++st) {
        const int l = st < 2 ? 0 : (st - 2) / 11;
        const int ph = st < 2 ? st : 2 + (st - 2) % 11;
        PP p = (PP)__builtin_amdgcn_kernarg_segment_ptr();
        asm volatile("" : "+s"(p));
        const int G = GDIM(), bid = BID();
        unsigned char* ws = p->ws;
        float* mod = (float*)(ws + O_MOD);
        bf16_t* hbuf = (bf16_t*)(ws + O_D);
        bf16_t* ybuf = (bf16_t*)(ws + O_B);
        float* x1buf = (float*)(ws + O_C);
        const float* ml = mod + l * 12288;
        switch (ph) {
        case 0:
            phase_mod(lds, p); if (bid < G - 64) phase_weights_a(lds, p, 0, bid, G - 64); else phase_s5pre(lds, p, 0, bid - (G - 64), 64);
            break;
        case 1:
            phase_ln<false, true>(p->in[0], nullptr, nullptr, nullptr, mod + 0, mod + 2048, hbuf);
            break;
        case 2: case 3:
            if (ph == 3 && bid < 128) { Gemm g{(const bf16_t*)(ws + O_E), (const bf16_t*)(ws + O_M2), 640, 512, 512}; OrderS5X S{128, bid}; EpiXend E{(float*)(ws + O_XEND)};
                gemm_phase(lds, g, S, E); }
            else { const int kh = ph == 3 ? (bid - 128) >> 6 : 0;
                Gemm g{hbuf + kh * 1024, (const bf16_t*)(ws + O_WIN) + kh * 1024, DM, DM, ph == 3 ? 1024 : DM}; OrderProj S; S.init(L, NPROJ - 256, G, ph == 3 ? (bid - 128) & 63 : bid); S.logit = ph == 3;
                EpiProj E{(bf16_t*)(ws + O_E), (bf16_t*)(ws + O_QKV), (bf16_t*)(ws + O_Z), (bf16_t*)(ws + O_SGS), (bf16_t*)(ws + O_SGG), (float*)(ws + (kh ? O_LOG2 : O_LOG))};
                gemm_phase(lds, g, S, E); }
            break;
        case 4:
            if (bid < 8) phase_carry(p, bid);
            else gdn_intra(lds, p, l, bid - 8, G - 8);
            break;
        case 5:
            if (bid < 32) gdn_scan(lds, p, bid);
            else {
                const int G2 = G - 32, c2 = bid - 32; unsigned* sb = (unsigned*)(ws + O_BAR) + 1280;
                { Gemm g{(const bf16_t*)(ws + O_E), (const bf16_t*)(ws + O_BT2), 640, 640, 640}; OrderS5Y S{G2, c2};
                  EpiS5Y E{(const bf16_t*)(ws + O_E), p->in[12] + l * 1024, (bf16_t*)(ws + O_ZS)}; gemm_phase(lds, g, S, E); }
                subbar(sb, (unsigned)((3 * l + 1) * G2));
                { Gemm g{(const bf16_t*)(ws + O_ZS), (const bf16_t*)(ws + O_WGLU), 1024, 1024, 1024}; StaticOrder S; S.init(L, 1024, G2, c2);
                  EpiGlu E{(const bf16_t*)(ws + O_ZS), p->in[14] + l * 1024, (bf16_t*)(ws + O_Y2)}; gemm_phase(lds, g, S, E); }
                subbar(sb, (unsigned)((3 * l + 2) * G2));
                { Gemm g{(const bf16_t*)(ws + O_Y2), (const bf16_t*)(ws + O_WUPS), 1024, 1024, 1024}; StaticOrder S; S.init(L, 2048, G2, c2);
                  EpiUp<0> E{(const bf16_t*)(ws + O_SGS), nullptr, (bf16_t*)(ws + O_T1)}; gemm_phase(lds, g, S, E); }
                __syncthreads();
                phase_weights_b(lds, p, l, c2, G2);
                if (l == 0) {
                    subbar(sb, (unsigned)(3 * G2));
                    if (c2 < G2 - 64) phase_weights_a(lds, p, 1, c2, G2 - 64); else phase_s5pre(lds, p, 1, c2 - (G2 - 64), 64);
                }
            }
            break;
        case 6:
            phase_normgate(p, l, G, bid);
            break;
        case 7: {
            Gemm g{(const bf16_t*)(ws + O_OBF), (const bf16_t*)(ws + O_WUPG), 1024, 1024, 1024}; StaticOrder S; S.init(L, 2048, G, bid);
            EpiUp<1> E{(const bf16_t*)(ws + O_SGG), (const bf16_t*)(ws + O_T1), (bf16_t*)(ws + O_MRG)}; gemm_phase(lds, g, S, E); } break;
        case 8: {
            const float* xin = l == 0 ? p->in[0] : p->out;
            Gemm g{(const bf16_t*)(ws + O_MRG), (const bf16_t*)(ws + O_WOUT), DM, DM, DM}; StaticOrder S; S.init(L, DM, G, bid);
            EpiBranch E{ml + 4096, ybuf}; gemm_phase(lds, g, S, E); (void)xin; } break;
        case 9:
            phase_ln<true, true, true>(l == 0 ? p->in[0] : p->out, p->in[22] + l * DM, p->in[23] + l * DM, x1buf, ml + 6144, ml + 8192, hbuf, ybuf);
            break;
        case 10: {
            Gemm g{hbuf, (const bf16_t*)(ws + O_WF1), DM, DM, DM}; StaticOrder S; S.init(L, 2 * FH, G, bid);
            EpiSwiglu E{(bf16_t*)(ws + O_A)}; gemm_phase(lds, g, S, E); } break;
        case 11: {
            Gemm g{(const bf16_t*)(ws + O_A), (const bf16_t*)(ws + O_WF2), FH, FH, FH}; StaticOrder S; S.init(L, DM, G, bid);
            EpiBranch E{ml + 10240, ybuf}; gemm_phase(lds, g, S, E); } break;
        default:
            if (l == 0) {
                phase_ln<true, true, true>(x1buf, p->in[26], p->in[27], p->out, mod + 12288, mod + 12288 + 2048, hbuf, ybuf);
            } else {
                phase_ln<true, false, true>(x1buf, p->in[26] + DM, p->in[27] + DM, p->out, nullptr, nullptr, nullptr, ybuf);
            }
            break;
        }
        if (st == 0) {
            if (G == 0x7fffffff) grid.sync();
            subbar((unsigned*)(ws + O_BAR) + 1472, (unsigned)G);
            unsigned* bar = (unsigned*)(ws + O_BAR);
            for (int x = 0; x < 8; ++x) { const unsigned c = __hip_atomic_load(bar + 512 + 64 * x, __ATOMIC_RELAXED, __HIP_MEMORY_SCOPE_AGENT); nxcc_act += c ? 1u : 0u; if (x == (int)my_xcc) nx_mine = c; }
        } else if (st != 23) gbar((unsigned*)(ws + O_BAR), (unsigned)st, nx_mine, nxcc_act, my_xcc);
    }
}

extern "C" void kernel_launch(void* const* d_in, const int* in_sizes, int n_in, void* d_out, int out_size, void* d_ws, size_t ws_size, hipStream_t stream) {
    static int grid_blocks = 0;
    if (grid_blocks == 0) {
        if (n_in != 28 || ws_size < WS_END) { fprintf(stderr, "kernel_launch: need 28 inputs and %zu bytes of workspace; got %d, %zu\n", (size_t)WS_END, n_in, ws_size); grid_blocks = -1; return; }
        int dev = 0, cus = 0, per_cu = 0;
        hipGetDevice(&dev);
        hipDeviceGetAttribute(&cus, hipDeviceAttributeMultiprocessorCount, dev);
        if (hipFuncSetAttribute((const void*)hybrid_fwd, hipFuncAttributeMaxDynamicSharedMemorySize, LDS_BYTES) != hipSuccess) { fprintf(stderr, "kernel_launch: hipFuncSetAttribute failed\n"); grid_blocks = -1; return; }
        hipOccupancyMaxActiveBlocksPerMultiprocessor(&per_cu, (const void*)hybrid_fwd, NTHR, LDS_BYTES);
        if (per_cu < 1) { fprintf(stderr, "kernel_launch: occupancy query says %d blocks per CU\n", per_cu); per_cu = 1; }
        (void)hipGetLastError();
        grid_blocks = cus;
    }
    if (grid_blocks < 0) return;
    Params p{};
    for (int i = 0; i < 28; ++i) p.in[i] = (const float*)d_in[i];
    p.out = (float*)d_out; p.ws = (unsigned char*)d_ws;
    if (hipMemsetAsync((char*)d_ws + O_BAR, 0, 8192, stream) != hipSuccess) { fprintf(stderr, "kernel_launch: hipMemsetAsync failed\n"); return; }
    void* args[] = {&p};
    hipError_t e = hipLaunchCooperativeKernel((const void*)hybrid_fwd, dim3(grid_blocks), dim3(NTHR), args, LDS_BYTES, stream);
    if (e != hipSuccess) fprintf(stderr, "cooperative launch failed: %s (grid %d)\n", hipGetErrorString(e), grid_blocks);
}
```
